# Optimizing an MI355X kernel written in HIP

```python
import jax, jax.numpy as jnp
from jax import lax
import numpy as np

D_MODEL = 1024
BATCH = 16
SEQ = 4096
DEPTH = 4

N_A_LAYERS = DEPTH // 2
CONV_WIDTH = 3
PATTERNS = ((128, 1), (512, 4), (2048, 16))
N_GROUPS = len(PATTERNS)
H_G = 8
HEAD_DIM = 64
D_FF = 4 * D_MODEL
EPS = 1e-5
ALIBI_MAX_BIAS = 8.0
NEG_INF = -1e30

kernel_name = 'yoco_shortconv_dilated_attn_trunk'


def rmsnorm(x, g):
    xf = x.astype(jnp.float32)
    y = xf * lax.rsqrt(jnp.mean(xf * xf, axis=-1, keepdims=True) + EPS)
    return (y * g.astype(jnp.float32)).astype(x.dtype)


def short_conv_mixer(h, w_in, conv_w, w_out):
    S = h.shape[1]
    b, c, u = jnp.split(h @ w_in, 3, axis=-1)
    up = jnp.pad(c * u, ((0, 0), (CONV_WIDTH - 1, 0), (0, 0)))
    conv = sum(conv_w[k] * up[:, CONV_WIDTH - 1 - k: CONV_WIDTH - 1 - k + S] for k in range(CONV_WIDTH))
    return (b * conv) @ w_out


def padded_len(S, window):
    return -(-S // window) * window


def to_blocks(t, dilation, blk, seq_pad):
    B, S = t.shape[:2]
    t = jnp.pad(t, [(0, 0), (0, seq_pad - S)] + [(0, 0)] * (t.ndim - 2))
    return t.reshape(B, seq_pad // (dilation * blk), blk, dilation, *t.shape[2:])


def kv_context(tb):
    prev = jnp.pad(tb, [(0, 0), (1, 0)] + [(0, 0)] * 4)[:, :-1]
    return jnp.concatenate([prev, tb], axis=2)


def dilated_branch(q, k_ctx, v_ctx, window, dilation, slopes):
    B, S, H, dh = q.shape
    blk = window // dilation
    seq_pad = padded_len(S, window)
    qb = to_blocks(q, dilation, blk, seq_pad)
    nb = qb.shape[1]
    s = jnp.einsum('bnqrhd,bnkrhd->bnrhqk', qb, k_ctx).astype(jnp.float32) * (dh ** -0.5)
    a = jnp.arange(blk)[:, None]
    c = jnp.arange(2 * blk)[None, :]
    j = blk + a - c
    n = jnp.arange(nb)[:, None, None]
    valid = (j >= 0) & (j <= blk) & ((n > 0) | (c >= blk))
    bias = -slopes[:, None, None] * (dilation * j).astype(jnp.float32)
    s = jnp.where(valid[None, :, None, None], s + bias, NEG_INF)
    lse = jax.nn.logsumexp(s, axis=-1)
    p = jnp.exp(s - lse[..., None]).astype(v_ctx.dtype)
    o = jnp.einsum('bnrhqk,bnkrhd->bnqrhd', p, v_ctx).reshape(B, seq_pad, H, dh)[:, :S]
    lse = jnp.transpose(lse, (0, 1, 4, 2, 3)).reshape(B, seq_pad, H)[:, :S]
    return o, lse


def setup_inputs(seed: int = 0) -> dict:
    key = jax.random.key(seed)
    ks = jax.random.split(key, 14)
    n_a = N_A_LAYERS
    n_b = DEPTH - N_A_LAYERS
    qw = N_GROUPS * H_G * HEAD_DIM
    f32 = jnp.float32
    nrm = lambda k, shape: jax.random.normal(k, shape, f32)
    return {
        'x': nrm(ks[0], (BATCH, SEQ, D_MODEL)),
        'norm_mix': 1.0 + 0.05 * nrm(ks[1], (DEPTH, D_MODEL)),
        'norm_mlp': 1.0 + 0.05 * nrm(ks[2], (DEPTH, D_MODEL)),
        'w_a_in': nrm(ks[3], (n_a, D_MODEL, 3 * D_MODEL)) * D_MODEL ** -0.5,
        'conv_w': nrm(ks[4], (n_a, CONV_WIDTH, D_MODEL)) * CONV_WIDTH ** -0.5,
        'w_a_out': nrm(ks[5], (n_a, D_MODEL, D_MODEL)) * D_MODEL ** -0.5,
        'norm_kv': 1.0 + 0.05 * nrm(ks[6], (D_MODEL,)),
        'w_kv': nrm(ks[7], (D_MODEL, 2 * qw)) * D_MODEL ** -0.5,
        'w_q': nrm(ks[8], (n_b, D_MODEL, qw)) * D_MODEL ** -0.5,
        'w_o': nrm(ks[9], (n_b, H_G * HEAD_DIM, D_MODEL)) * (H_G * HEAD_DIM) ** -0.5,
        'w_up': nrm(ks[10], (DEPTH, D_MODEL, D_FF)) * D_MODEL ** -0.5,
        'w_down': nrm(ks[11], (DEPTH, D_FF, D_MODEL)) * (0.5 * D_FF ** -0.5),
        'norm_final': 1.0 + 0.05 * nrm(ks[12], (D_MODEL,)),
    }


def reference(x, norm_mix, norm_mlp, w_a_in, conv_w, w_a_out, norm_kv, w_kv, w_q, w_o, w_up, w_down, norm_final):
    B, S, _ = x.shape
    slopes = 2.0 ** (-ALIBI_MAX_BIAS * jnp.arange(1, H_G + 1, dtype=jnp.float32) / H_G)
    h = x
    shared = []
    for l in range(DEPTH):
        if l < N_A_LAYERS:
            h = h + short_conv_mixer(rmsnorm(h, norm_mix[l]), w_a_in[l], conv_w[l], w_a_out[l])
        else:
            if l == N_A_LAYERS:
                kv = (rmsnorm(h, norm_kv) @ w_kv).reshape(B, S, N_GROUPS, 2, H_G, HEAD_DIM)
                for g, (window, dil) in enumerate(PATTERNS):
                    blk = window // dil
                    sp = padded_len(S, window)
                    shared.append((kv_context(to_blocks(kv[:, :, g, 0], dil, blk, sp)),
                                   kv_context(to_blocks(kv[:, :, g, 1], dil, blk, sp))))
            i = l - N_A_LAYERS
            q = (rmsnorm(h, norm_mix[l]) @ w_q[i]).reshape(B, S, N_GROUPS, H_G, HEAD_DIM)
            outs, lses = [], []
            for g, (window, dil) in enumerate(PATTERNS):
                o_g, lse_g = dilated_branch(q[:, :, g], shared[g][0], shared[g][1], window, dil, slopes)
                outs.append(o_g.astype(jnp.float32))
                lses.append(lse_g)
            wts = jax.nn.softmax(jnp.stack(lses), axis=0)
            o = jnp.sum(wts[..., None] * jnp.stack(outs), axis=0).astype(h.dtype)
            h = h + o.reshape(B, S, H_G * HEAD_DIM) @ w_o[i]
        hn = rmsnorm(h, norm_mlp[l])
        h = h + jnp.square(jax.nn.relu(hn @ w_up[l])) @ w_down[l]
    return rmsnorm(h, norm_final)
```

```cpp
#include <hip/hip_runtime.h>
#include <hip/hip_cooperative_groups.h>
#include <cstdio>
#include <cstdint>
namespace cg = cooperative_groups;
namespace pg8 {
#define PG8_LAS __attribute__((address_space(3)))
typedef unsigned short bf16_t;
typedef short bf16x8 __attribute__((ext_vector_type(8)));
typedef float f32x4 __attribute__((ext_vector_type(4)));
typedef unsigned u32x4 __attribute__((ext_vector_type(4)));
constexpr int BM = 256, BK = 64, HALF = 128, HTB = HALF * BK * 2  , STAGE_BYTES = 8 * HTB, NXCD = 8, WGM = 8;

__host__ __device__ __forceinline__ int lds_byte(int r, int c) { const int st = (r >> 4) * 2 + (c >> 5), rr = r & 15, cc = c & 31, ob = rr * 64 + cc * 2; return st * 1024 + (ob ^ (((ob >> 9) & 1) << 5)); }
__host__ __device__ __forceinline__ void stage_rc(int b, int& R, int& C) { const int st = b / 1024, sb = b % 1024, swz = sb ^ (((sb >> 9) & 1) << 5); R = (st >> 1) * 16 + swz / 64; C = (st & 1) * 32 + (swz % 64) / 2; }
__host__ __device__ __forceinline__ int perm32(int rho) { const int n = rho >> 4, i = rho & 15; return 8 * (i >> 2) + 4 * n + (i & 3); }

struct Unit { int pm, pn; };
struct Gemm { const bf16_t* A; const bf16_t* Bt; int M, N, K; };

struct StaticOrder {
    int nM, nN, nwg, G, c;
    __host__ __device__ void init(int M, int N, int G_, int c_) { nM = M / BM; nN = N / BM; nwg = nM * nN; G = G_; c = c_; }
    __host__ __device__ bool next(int i, Unit& u) const {
        const long L = (long)i * G + c; if (L >= nwg) return false;
        int wgid = (int)L; { const int q = nwg / NXCD, r = nwg % NXCD, xcd = wgid % NXCD, off = wgid / NXCD; wgid = (xcd < r ? xcd * (q + 1) : r * (q + 1) + (xcd - r) * q) + off; }
        const int nig = WGM * nN, gid = wgid / nig, fm = gid * WGM, gsz = (nM - fm) < WGM ? (nM - fm) : WGM;
        u.pm = fm + ((wgid % nig) % gsz); u.pn = (wgid % nig) / gsz; return true;
    }
    __device__ __forceinline__ void a_ready(const Unit&) const {}
    __device__ __forceinline__ void done(const Unit&) const {}
};

__device__ __forceinline__ unsigned cvt_pk_bf16(float lo, float hi) { unsigned r; asm volatile("v_cvt_pk_bf16_f32 %0, %1, %2" : "=v"(r) : "v"(lo), "v"(hi)); return r; }

template <class Epi, class Sched, bool ALIGN_EPI = false, bool SP2 = false>
__device__ __forceinline__ void gemm_phase(PG8_LAS unsigned char* lds, const Gemm g, const Sched& S, const Epi& E) {
    int tid_ = threadIdx.x; asm volatile("" : "+v"(tid_));
    const int tid = tid_, wid = __builtin_amdgcn_readfirstlane(tid >> 6), lane = tid & 63, wr = wid >> 2, wc = wid & 3, fr = lane & 15, fq = lane >> 4;
    const int K = g.K, nt = K / BK;
    unsigned voffA[2], voffB[2];
#pragma unroll
    for (int i = 0; i < 2; ++i) { int R, C; stage_rc(tid * 16 + i * 8192, R, C); const int Rb = Epi::PERM ? ((R & ~31) + perm32(R & 31)) : R;
        voffA[i] = (unsigned)(R * K + C) * 2u; voffB[i] = (unsigned)(Rb * K + C) * 2u; }
    const size_t kstep = (size_t)(BK * 2);
    const size_t hstep = (size_t)HALF * K * 2;
    const size_t tstep = 2 * hstep;
    const unsigned ldsw = (unsigned)wid * 1024u;
    const int aoff = lds_byte(wr * 64 + fr, fq * 8), boff = lds_byte(wc * 32 + fr, fq * 8);
#define PG8_SA(b, h) (((b) * 2 + (h)) * HTB)
#define PG8_SB(b, h) ((4 + (b) * 2 + (h)) * HTB)
#define PG8_STAGE(bufoff, gbase, voff) do { _Pragma("unroll") for (int _i = 0; _i < 2; ++_i) \
        __builtin_amdgcn_global_load_lds((const unsigned*)((const char*)(gbase) + (voff)[_i]), (PG8_LAS unsigned*)(lds + (bufoff) + ldsw + _i * 8192), 16, 0, 0); } while (0)
#define PG8_LDA(dst, b, h) do { _Pragma("unroll") for (int m = 0; m < 4; ++m) _Pragma("unroll") for (int k = 0; k < 2; ++k) dst[m][k] = *(const PG8_LAS bf16x8*)(lds + PG8_SA(b, h) + aoff + m * 2048 + k * 1024); } while (0)
#define PG8_LDB(dst, b, h) do { _Pragma("unroll") for (int n = 0; n < 2; ++n) _Pragma("unroll") for (int k = 0; k < 2; ++k) dst[n][k] = *(const PG8_LAS bf16x8*)(lds + PG8_SB(b, h) + boff + n * 2048 + k * 1024); } while (0)
#define PG8_MMA(ai, bj, At, Bt) do { __builtin_amdgcn_s_setprio(1); _Pragma("unroll") for (int m = 0; m < 4; ++m) _Pragma("unroll") for (int n = 0; n < 2; ++n) _Pragma("unroll") for (int k = 0; k < 2; ++k) \
        acc[ai][bj][m][n] = __builtin_amdgcn_mfma_f32_16x16x32_bf16(Bt[n][k], At[m][k], acc[ai][bj][m][n], 0, 0, 0); __builtin_amdgcn_s_setprio(0); } while (0)
#define PG8_WAIT_V(n) asm volatile("s_waitcnt vmcnt(" #n ")" ::: "memory")
#define PG8_WAIT_L(n) asm volatile("s_waitcnt lgkmcnt(" #n ")" ::: "memory")
#define PG8_BAR __builtin_amdgcn_s_barrier()
#define PG8_SCHED __builtin_amdgcn_sched_barrier(0)
    Unit cur, nxt; int ui = 0;
    if (!S.next(0, cur)) return;
    f32x4 acc[2][2][4][2];
#pragma unroll
    for (int a = 0; a < 2; ++a)
#pragma unroll
        for (int b = 0; b < 2; ++b)
#pragma unroll
            for (int m = 0; m < 4; ++m)
#pragma unroll
                for (int n = 0; n < 2; ++n) acc[a][b][m][n] = (f32x4){0.f, 0.f, 0.f, 0.f};
    bf16x8 At[4][2], B0[2][2], B1[2][2];
    const char* cA = (const char*)g.A + (size_t)cur.pm * tstep; const char* cB = (const char*)g.Bt + (size_t)cur.pn * tstep;
    S.a_ready(cur);
    if constexpr (SP2) {
        PG8_STAGE(PG8_SB(0, 0), cB, voffB); PG8_STAGE(PG8_SB(0, 1), cB + hstep, voffB); PG8_STAGE(PG8_SA(0, 0), cA, voffA); PG8_STAGE(PG8_SA(0, 1), cA + hstep, voffA);
        if (wr == 1) PG8_BAR;
        PG8_WAIT_V(2); PG8_BAR;
        PG8_STAGE(PG8_SB(1, 0), cB + kstep, voffB); PG8_STAGE(PG8_SA(1, 0), cA + kstep, voffA); PG8_STAGE(PG8_SB(1, 1), cB + hstep + kstep, voffB);
        PG8_WAIT_V(6); PG8_BAR;
    } else {
        PG8_STAGE(PG8_SB(0, 0), cB, voffB); PG8_STAGE(PG8_SA(0, 0), cA, voffA); PG8_STAGE(PG8_SB(0, 1), cB + hstep, voffB); PG8_STAGE(PG8_SA(0, 1), cA + hstep, voffA);
        if (wr == 1) PG8_BAR;
        PG8_WAIT_V(4); PG8_BAR;
        PG8_STAGE(PG8_SB(1, 0), cB + kstep, voffB); PG8_STAGE(PG8_SA(1, 0), cA + kstep, voffA); PG8_STAGE(PG8_SB(1, 1), cB + hstep + kstep, voffB);
        PG8_WAIT_V(6); PG8_BAR;
    }
    for (;;) {
        const bool has_next = S.next(ui + 1, nxt);
        const char* nA = has_next ? (const char*)g.A + (size_t)nxt.pm * tstep : cA; const char* nB = has_next ? (const char*)g.Bt + (size_t)nxt.pn * tstep : cB;
        for (int t = 0; t < nt; t += 2) {
            const bool last = (t == nt - 2);
            const char* a1 = cA + (size_t)(t + 1) * kstep;
            const char* a2 = last ? nA : cA + (size_t)(t + 2) * kstep; const char* b2 = last ? nB : cB + (size_t)(t + 2) * kstep;
            const char* a3 = a2 + kstep; const char* b3 = b2 + kstep;
            if (last && has_next) S.a_ready(nxt);
            if constexpr (SP2) {
            PG8_LDB(B0, 0, 0); PG8_LDB(B1, 0, 1); PG8_SCHED; PG8_LDA(At, 0, 0); PG8_STAGE(PG8_SA(1, 1), a1 + hstep, voffA);
            PG8_WAIT_V(8); PG8_WAIT_L(0); PG8_BAR; PG8_MMA(0, 0, At, B0); PG8_MMA(0, 1, At, B1); PG8_BAR; PG8_SCHED;
            PG8_LDA(At, 0, 1); PG8_STAGE(PG8_SB(0, 0), b2, voffB); PG8_STAGE(PG8_SB(0, 1), b2 + hstep, voffB); PG8_STAGE(PG8_SA(0, 0), a2, voffA);
            PG8_WAIT_V(8); PG8_WAIT_L(0); PG8_BAR; PG8_MMA(1, 0, At, B0); PG8_MMA(1, 1, At, B1); PG8_BAR; PG8_SCHED;
            PG8_LDB(B0, 1, 0); PG8_LDB(B1, 1, 1); PG8_SCHED; PG8_LDA(At, 1, 0); PG8_STAGE(PG8_SA(0, 1), a2 + hstep, voffA);
            PG8_WAIT_V(8); PG8_WAIT_L(0); PG8_BAR; PG8_MMA(0, 0, At, B0); PG8_MMA(0, 1, At, B1); PG8_BAR; PG8_SCHED;
            PG8_LDA(At, 1, 1); PG8_STAGE(PG8_SB(1, 0), b3, voffB); PG8_STAGE(PG8_SB(1, 1), b3 + hstep, voffB); PG8_STAGE(PG8_SA(1, 0), a3, voffA);
            PG8_WAIT_V(8); PG8_WAIT_L(0); PG8_BAR; PG8_MMA(1, 0, At, B0); PG8_MMA(1, 1, At, B1); PG8_BAR; PG8_SCHED;
            } else {
            PG8_LDB(B0, 0, 0); PG8_SCHED; PG8_LDA(At, 0, 0); PG8_STAGE(PG8_SA(1, 1), a1 + hstep, voffA);
            PG8_WAIT_L(8); PG8_BAR; PG8_WAIT_L(0); PG8_MMA(0, 0, At, B0); PG8_BAR; PG8_SCHED;
            PG8_LDB(B1, 0, 1); PG8_STAGE(PG8_SB(0, 0), b2, voffB);
            PG8_BAR; PG8_WAIT_L(0); PG8_MMA(0, 1, At, B1); PG8_BAR;
            PG8_LDA(At, 0, 1); PG8_STAGE(PG8_SA(0, 0), a2, voffA);
            PG8_BAR; PG8_WAIT_L(0); PG8_MMA(1, 0, At, B0); PG8_BAR; PG8_SCHED;
            PG8_STAGE(PG8_SB(0, 1), b2 + hstep, voffB);
            PG8_WAIT_V(6); PG8_BAR; PG8_MMA(1, 1, At, B1); PG8_BAR;
            PG8_LDB(B0, 1, 0); PG8_SCHED; PG8_LDA(At, 1, 0); PG8_STAGE(PG8_SA(0, 1), a2 + hstep, voffA);
            PG8_WAIT_L(8); PG8_BAR; PG8_WAIT_L(0); PG8_MMA(0, 0, At, B0); PG8_BAR; PG8_SCHED;
            PG8_LDB(B1, 1, 1); PG8_STAGE(PG8_SB(1, 0), b3, voffB);
            PG8_BAR; PG8_WAIT_L(0); PG8_MMA(0, 1, At, B1); PG8_BAR;
            PG8_LDA(At, 1, 1); PG8_STAGE(PG8_SA(1, 0), a3, voffA);
            PG8_BAR; PG8_WAIT_L(0); PG8_MMA(1, 0, At, B0); PG8_BAR; PG8_SCHED;
            PG8_STAGE(PG8_SB(1, 1), b3 + hstep, voffB);
            PG8_WAIT_V(6); PG8_BAR; PG8_MMA(1, 1, At, B1); PG8_BAR;
            }
        }
        if constexpr (ALIGN_EPI) { if (wr == 0) PG8_BAR; }
        if constexpr (!Epi::AFTER_DRAIN) { E(acc, cur, wr, wc, fr, fq); S.done(cur); }
        if (!has_next) break;
#pragma unroll
        for (int a = 0; a < 2; ++a)
#pragma unroll
            for (int b = 0; b < 2; ++b)
#pragma unroll
                for (int m = 0; m < 4; ++m)
#pragma unroll
                    for (int n = 0; n < 2; ++n) acc[a][b][m][n] = (f32x4){0.f, 0.f, 0.f, 0.f};
        cur = nxt; cA = nA; cB = nB; ++ui;
        if constexpr (ALIGN_EPI) { if (wr == 1) PG8_BAR; }
    }
    PG8_WAIT_V(0);
    if constexpr (!ALIGN_EPI) { if (wr == 0) PG8_BAR; }
    PG8_BAR;
    if constexpr (Epi::AFTER_DRAIN) { E.fused(acc, cur, wr, wc, fr, fq, lds, wid, lane); S.done(cur); }
#undef PG8_SA
#undef PG8_SB
#undef PG8_STAGE
#undef PG8_LDA
#undef PG8_LDB
#undef PG8_MMA
#undef PG8_WAIT_V
#undef PG8_WAIT_L
#undef PG8_BAR
#undef PG8_SCHED
}
}

#define LAS __attribute__((address_space(3)))
typedef unsigned short bf16;
typedef float f32x4 __attribute__((ext_vector_type(4)));
typedef short bf16x8 __attribute__((ext_vector_type(8)));
typedef short s16x4 __attribute__((ext_vector_type(4)));
typedef unsigned u32x4 __attribute__((ext_vector_type(4)));
typedef unsigned u32x2 __attribute__((ext_vector_type(2)));
constexpr int NBATCH = 16, SEQ = 4096, D = 1024, FF = 4096, M = NBATCH * SEQ;
constexpr int NQ = 1536, NKV = 3072, NQKV = NKV + NQ, OD = 512;
constexpr int MCH = 16384, MCA = 32768;
constexpr size_t MiB = 1u << 20;
constexpr size_t WS_WAIN = 1 * MiB, WS_WAOUT = 13 * MiB, WS_WQKV = 17 * MiB, WS_WQ3 = 26 * MiB, WS_WO = 29 * MiB, WS_WUP = 31 * MiB, WS_WDN = 63 * MiB;
constexpr size_t WS_SSQ = 95 * MiB, WS_LSE = 99 * MiB, WS_HB = 102 * MiB, WS_R1 = 230 * MiB, WS_R2 = 614 * MiB, WS_OG1 = 870 * MiB, WS_OG2 = 934 * MiB, WS_LSE3 = 998 * MiB, WS_SSQ2 = 1004 * MiB, WS_END = 1008 * MiB;
constexpr int LDS_BYTES = 163840;
constexpr int NTHREADS = 512, NWAVES = 8;

__device__ __forceinline__ int fresh_tid() { int t = threadIdx.x; asm volatile("" : "+v"(t)); return t; }
__device__ __forceinline__ unsigned pk2(float lo, float hi) { return pg8::cvt_pk_bf16(lo, hi); }
__device__ __forceinline__ float bflo(unsigned u) { return __uint_as_float(u << 16); }
__device__ __forceinline__ float bfhi(unsigned u) { return __uint_as_float(u & 0xffff0000u); }
__device__ __forceinline__ float quad16_sum(float x) {
    const auto s = __builtin_amdgcn_permlane16_swap(__float_as_uint(x), __float_as_uint(x), false, false); x = __uint_as_float(s[0]) + __uint_as_float(s[1]);
    const auto t = __builtin_amdgcn_permlane32_swap(__float_as_uint(x), __float_as_uint(x), false, false); return __uint_as_float(t[0]) + __uint_as_float(t[1]); }
__device__ __forceinline__ float quad16_max(float x) {
    const auto s = __builtin_amdgcn_permlane16_swap(__float_as_uint(x), __float_as_uint(x), false, false); x = fmaxf(__uint_as_float(s[0]), __uint_as_float(s[1]));
    const auto t = __builtin_amdgcn_permlane32_swap(__float_as_uint(x), __float_as_uint(x), false, false); return fmaxf(__uint_as_float(t[0]), __uint_as_float(t[1])); }

namespace pg8 {
__device__ __forceinline__ void row_rstd(const float* ssq, int row0, int fq, float (&rs)[2][4]) {
#pragma unroll
    for (int ai = 0; ai < 2; ++ai)
#pragma unroll
        for (int m = 0; m < 4; ++m) {
            const f32x4 v = *(const f32x4*)(ssq + (size_t)(row0 + ai * HALF + m * 16) * 16 + 4 * fq);
            float s = (v[0] + v[1]) + (v[2] + v[3]);
            s += __shfl_xor(s, 16); s += __shfl_xor(s, 32);
            rs[ai][m] = rsqrtf(s * (1.0f / 1024.0f) + 1e-5f);
        }
}
__device__ __forceinline__ void row_r2(const float* ssq, int row0, int fq, float (&rs)[2][4]) {
#pragma unroll
    for (int ai = 0; ai < 2; ++ai)
#pragma unroll
        for (int m = 0; m < 4; ++m) {
            const f32x4 v = *(const f32x4*)(ssq + (size_t)(row0 + ai * HALF + m * 16) * 16 + 4 * fq);
            float s = (v[0] + v[1]) + (v[2] + v[3]);
            s += __shfl_xor(s, 16); s += __shfl_xor(s, 32);
            rs[ai][m] = 1.0f / (s * (1.0f / 1024.0f) + 1e-5f);
        }
}
template <int ACT> struct EpiScaleBf16 {
    static constexpr bool PERM = true, AFTER_DRAIN = false;
    bf16_t* O0; int ldc0; bf16_t* O1; int ldc1; int split; const float* ssq;
    __device__ __forceinline__ void operator()(const f32x4 (&acc)[2][2][4][2], const Unit& u, int wr, int wc, int fr, int fq) const {
        const int row0 = u.pm * BM + wr * 64 + fr; int colt = u.pn * BM; bf16_t* base = O0; int ldc = ldc0;
        if (colt >= split) { base = O1; ldc = ldc1; colt -= split; }
        const int col0 = colt + wc * 32 + 8 * fq;
        float rs[2][4];
        if (ACT == 1) {
#pragma unroll
            for (int i = 0; i < 8; ++i) rs[i >> 2][i & 3] = 1.0f;
        } else row_rstd(ssq, row0, fq, rs);
#pragma unroll
        for (int ai = 0; ai < 2; ++ai)
#pragma unroll
            for (int m = 0; m < 4; ++m) { bf16_t* rowp = base + (size_t)(row0 + ai * HALF + m * 16) * ldc + col0; const float r = rs[ai][m];
#pragma unroll
                for (int bj = 0; bj < 2; ++bj) { f32x4 v0 = acc[ai][bj][m][0] * r, v1 = acc[ai][bj][m][1] * r;
                    if (ACT == 1) {
#pragma unroll
                        for (int j = 0; j < 4; ++j) { const float a = fmaxf(v0[j], 0.f), b = fmaxf(v1[j], 0.f); v0[j] = a * a; v1[j] = b * b; } }
                    u32x4 w; w.x = cvt_pk_bf16(v0[0], v0[1]); w.y = cvt_pk_bf16(v0[2], v0[3]); w.z = cvt_pk_bf16(v1[0], v1[1]); w.w = cvt_pk_bf16(v1[2], v1[3]);
                    *(u32x4*)(rowp + bj * HALF) = w; } }
    }
};
struct EpiQKV {
    static constexpr bool PERM = true, AFTER_DRAIN = false;
    bf16_t* KV; bf16_t* Q; int nkv; const float* ssq;
    __device__ __forceinline__ void operator()(const f32x4 (&acc)[2][2][4][2], const Unit& u, int wr, int wc, int fr, int fq) const {
        const int row0 = u.pm * BM + wr * 64 + fr; const int colt = u.pn * BM;
        float rs[2][4]; row_rstd(ssq, row0, fq, rs);
        int g, h0; size_t plane0; bf16_t* base; int bstride;
        if (colt < nkv) { g = colt >> 10; h0 = (colt >> 6) & 7; plane0 = (size_t)(g * 2 + ((colt >> 9) & 1)) * 8; bstride = 48; base = KV; }
        else { const int cq = colt - nkv; g = cq >> 9; h0 = (cq >> 6) & 7; plane0 = (size_t)g * 8; bstride = 24; base = Q; }
        const int ld = 2 * g, dmask = (1 << ld) - 1, sh = 12 - ld;
        const int d0 = (wc & 1) * 32 + 8 * fq;
#pragma unroll
        for (int ai = 0; ai < 2; ++ai)
#pragma unroll
            for (int m = 0; m < 4; ++m) { const int row = row0 + ai * HALF + m * 16, b = row >> 12, pos = row & 4095, pp = ((pos & dmask) << sh) + (pos >> ld); const float r = rs[ai][m];
#pragma unroll
                for (int bj = 0; bj < 2; ++bj) { const f32x4 v0 = acc[ai][bj][m][0] * r, v1 = acc[ai][bj][m][1] * r;
                    const int h = h0 + 2 * bj + (wc >> 1);
                    u32x4 w; w.x = cvt_pk_bf16(v0[0], v0[1]); w.y = cvt_pk_bf16(v0[2], v0[3]); w.z = cvt_pk_bf16(v1[0], v1[1]); w.w = cvt_pk_bf16(v1[2], v1[3]);
                    *(u32x4*)(base + ((plane0 + (size_t)b * bstride + h) * 4096 + pp) * 64 + d0) = w; } }
    }
};
struct EpiCU {
    static constexpr bool PERM = true, AFTER_DRAIN = false;
    bf16_t* CU; const float* ssq;
    __device__ __forceinline__ void operator()(const f32x4 (&acc)[2][2][4][2], const Unit& u, int wr, int wc, int fr, int fq) const {
        const int row0 = u.pm * BM + wr * 64 + fr, col0 = u.pn * HALF + wc * 32 + 8 * fq;
        float rs[2][4]; row_rstd(ssq, row0, fq, rs);
#pragma unroll
        for (int ai = 0; ai < 2; ++ai)
#pragma unroll
            for (int m = 0; m < 4; ++m) { bf16_t* rowp = CU + (size_t)(row0 + ai * HALF + m * 16) * 1024 + col0; const float r2 = rs[ai][m] * rs[ai][m];
                const f32x4 v0 = acc[ai][0][m][0] * acc[ai][1][m][0] * r2, v1 = acc[ai][0][m][1] * acc[ai][1][m][1] * r2;
                u32x4 w; w.x = cvt_pk_bf16(v0[0], v0[1]); w.y = cvt_pk_bf16(v0[2], v0[3]); w.z = cvt_pk_bf16(v1[0], v1[1]); w.w = cvt_pk_bf16(v1[2], v1[3]);
                *(u32x4*)rowp = w; }
    }
};
struct EpiBConv {
    static constexpr bool PERM = true, AFTER_DRAIN = false;
    const bf16_t* CU; bf16_t* Y; const float* cw; const float* ssq;
    __device__ __forceinline__ void operator()(const f32x4 (&acc)[2][2][4][2], const Unit& u, int wr, int wc, int fr, int fq) const {
        const int row0 = u.pm * BM + wr * 64 + fr, col0 = u.pn * BM + wc * 32 + 8 * fq;
        float rs[2][4]; row_rstd(ssq, row0, fq, rs);
#pragma unroll
        for (int bj = 0; bj < 2; ++bj) {
            const int col = col0 + bj * HALF;
            f32x4 w0[2], w1[2], w2[2];
#pragma unroll
            for (int n = 0; n < 2; ++n) { w0[n] = *(const f32x4*)(cw + col + 4 * n); w1[n] = *(const f32x4*)(cw + 1024 + col + 4 * n); w2[n] = *(const f32x4*)(cw + 2048 + col + 4 * n); }
#pragma unroll
            for (int ai = 0; ai < 2; ++ai)
#pragma unroll
                for (int m = 0; m < 4; ++m) { const int row = row0 + ai * HALF + m * 16, t = row & 4095; const float r = rs[ai][m];
                    const bf16_t* cp = CU + (size_t)row * 1024 + col;
                    const u32x4 c0 = *(const u32x4*)cp; u32x4 c1 = *(const u32x4*)(cp - (t >= 1 ? 1024 : 0)), c2 = *(const u32x4*)(cp - (t >= 2 ? 2048 : 0));
                    if (t < 1) c1 = (u32x4){0u, 0u, 0u, 0u};
                    if (t < 2) c2 = (u32x4){0u, 0u, 0u, 0u};
                    const unsigned a0[4] = {c0.x, c0.y, c0.z, c0.w}, a1[4] = {c1.x, c1.y, c1.z, c1.w}, a2[4] = {c2.x, c2.y, c2.z, c2.w};
                    float y[8];
#pragma unroll
                    for (int e = 0; e < 4; ++e) { const int n = e >> 1, k = 2 * (e & 1);
                        const float lo = w0[n][k] * __uint_as_float(a0[e] << 16) + w1[n][k] * __uint_as_float(a1[e] << 16) + w2[n][k] * __uint_as_float(a2[e] << 16);
                        const float hi = w0[n][k + 1] * __uint_as_float(a0[e] & 0xffff0000u) + w1[n][k + 1] * __uint_as_float(a1[e] & 0xffff0000u) + w2[n][k + 1] * __uint_as_float(a2[e] & 0xffff0000u);
                        y[2 * e] = acc[ai][bj][m][n][k] * r * lo; y[2 * e + 1] = acc[ai][bj][m][n][k + 1] * r * hi; }
                    u32x4 w; w.x = cvt_pk_bf16(y[0], y[1]); w.y = cvt_pk_bf16(y[2], y[3]); w.z = cvt_pk_bf16(y[4], y[5]); w.w = cvt_pk_bf16(y[6], y[7]);
                    *(u32x4*)(Y + (size_t)row * 1024 + col) = w; }
        }
    }
};
struct EpiRes {
    static constexpr bool PERM = true, AFTER_DRAIN = false;
    bf16_t* hb; float* ssq; const float* ssq_scale;
    __device__ __forceinline__ void operator()(const f32x4 (&acc)[2][2][4][2], const Unit& u, int wr, int wc, int fr, int fq) const {
        const int row0 = u.pm * BM + wr * 64 + fr, col0 = u.pn * BM + wc * 32 + 8 * fq;
        float r2[2][4];
        if (ssq_scale) row_r2(ssq_scale, row0, fq, r2);
        else {
#pragma unroll
            for (int i = 0; i < 8; ++i) r2[i >> 2][i & 3] = 1.0f; }
#pragma unroll
        for (int ai = 0; ai < 2; ++ai) {
            u32x4 bs[4][2];
#pragma unroll
            for (int m = 0; m < 4; ++m)
#pragma unroll
                for (int bj = 0; bj < 2; ++bj) bs[m][bj] = *(const u32x4*)(hb + (size_t)(row0 + ai * HALF + m * 16) * 1024 + col0 + bj * HALF);
#pragma unroll
            for (int m = 0; m < 4; ++m) { const int row = row0 + ai * HALF + m * 16; bf16_t* rowp = hb + (size_t)row * 1024 + col0; float s = 0.f;
#pragma unroll
                for (int bj = 0; bj < 2; ++bj) { const u32x4 b = bs[m][bj]; const f32x4 a0 = acc[ai][bj][m][0] * r2[ai][m], a1 = acc[ai][bj][m][1] * r2[ai][m];
                    const float o0 = __uint_as_float(b.x << 16) + a0[0], o1 = __uint_as_float(b.x & 0xffff0000u) + a0[1], o2 = __uint_as_float(b.y << 16) + a0[2], o3 = __uint_as_float(b.y & 0xffff0000u) + a0[3];
                    const float o4 = __uint_as_float(b.z << 16) + a1[0], o5 = __uint_as_float(b.z & 0xffff0000u) + a1[1], o6 = __uint_as_float(b.w << 16) + a1[2], o7 = __uint_as_float(b.w & 0xffff0000u) + a1[3];
                    s += ((o0 * o0 + o1 * o1) + (o2 * o2 + o3 * o3)) + ((o4 * o4 + o5 * o5) + (o6 * o6 + o7 * o7));
                    u32x4 w; w.x = cvt_pk_bf16(o0, o1); w.y = cvt_pk_bf16(o2, o3); w.z = cvt_pk_bf16(o4, o5); w.w = cvt_pk_bf16(o6, o7);
                    *(u32x4*)(rowp + bj * HALF) = w; }
                s += __shfl_xor(s, 16); s += __shfl_xor(s, 32);
                if (fq == 0) ssq[(size_t)row * 16 + u.pn * 4 + wc] = s; }
            asm volatile("" ::: "memory"); }
    }
};
}

#ifdef SKIP_GEMM
#define GEMM_PHASE(...) (void)
template <class A, class B, bool C, bool D2, class... T> __device__ __forceinline__ void gemm_skip(T...) {}
#undef GEMM_PHASE
#define GEMM_PHASE gemm_skip
#else
#define GEMM_PHASE pg8::gemm_phase
#endif
struct Params { const float* in[13]; float* out; unsigned char* ws; };

struct TItem { const float* src; const float* gain; bf16* dst; int K, Nsrc; float scale; };
__device__ __forceinline__ void titem_decode(const Params& P, int it, TItem& T) {
    unsigned char* ws = P.ws;
    constexpr int I_AIN = 16 * 96, I_AOUT = 16 * 32, I_KV = 16 * 96, I_Q = 16 * 48, I_O = 8 * 32, I_UP = 16 * 128, I_DN = 64 * 32;
    int r = it; const float* src; const float* gain; bf16* dst; int K, Nsrc, ncols, mode = 0; float scale = 1.0f;
    if (r < 2 * I_AIN) { const int l = r / I_AIN; r -= l * I_AIN; src = P.in[3] + (size_t)l * 1024 * 3072; gain = P.in[1] + l * 1024; dst = (bf16*)(ws + WS_WAIN + (size_t)l * 6 * MiB); K = 1024; Nsrc = 3072; ncols = 3072; mode = 1; }
    else if ((r -= 2 * I_AIN) < 2 * I_AOUT) { const int l = r / I_AOUT; r -= l * I_AOUT; src = P.in[5] + (size_t)l * 1024 * 1024; gain = nullptr; dst = (bf16*)(ws + WS_WAOUT + (size_t)l * 2 * MiB); K = 1024; Nsrc = 1024; ncols = 1024; }
    else if ((r -= 2 * I_AOUT) < I_KV) { src = P.in[7]; gain = P.in[6]; dst = (bf16*)(ws + WS_WQKV); K = 1024; Nsrc = 3072; ncols = 3072; }
    else if ((r -= I_KV) < I_Q) { src = P.in[8]; gain = P.in[1] + 2 * 1024; dst = (bf16*)(ws + WS_WQKV) + (size_t)3072 * 1024; K = 1024; Nsrc = 1536; ncols = 1536; scale = 0.125f * 1.4426950408889634f; }
    else if ((r -= I_Q) < I_Q) { src = P.in[8] + (size_t)1024 * 1536; gain = P.in[1] + 3 * 1024; dst = (bf16*)(ws + WS_WQ3); K = 1024; Nsrc = 1536; ncols = 1536; scale = 0.125f * 1.4426950408889634f; }
    else if ((r -= I_Q) < 2 * I_O) { const int l = r / I_O; r -= l * I_O; src = P.in[9] + (size_t)l * 512 * 1024; gain = nullptr; dst = (bf16*)(ws + WS_WO + (size_t)l * MiB); K = 512; Nsrc = 1024; ncols = 1024; }
    else if ((r -= 2 * I_O) < 4 * I_UP) { const int l = r / I_UP; r -= l * I_UP; src = P.in[10] + (size_t)l * 1024 * 4096; gain = P.in[2] + l * 1024; dst = (bf16*)(ws + WS_WUP + (size_t)l * 8 * MiB); K = 1024; Nsrc = 4096; ncols = 4096; }
    else { r -= 4 * I_UP; const int l = r / I_DN; r -= l * I_DN; src = P.in[11] + (size_t)l * 4096 * 1024; gain = nullptr; dst = (bf16*)(ws + WS_WDN + (size_t)l * 8 * MiB); K = 4096; Nsrc = 1024; ncols = 1024; }
    const int nblk = ncols / 32, kb = r / nblk, nb = r % nblk, k0 = 64 * kb, n0 = 32 * nb;
    int s0 = n0;
    if (mode == 1 && n0 >= 1024) { const int t = (n0 - 1024) >> 8, wv = (n0 - 1024) & 255; s0 = (wv < 128) ? (1024 + 128 * t + wv) : (2048 + 128 * t + (wv - 128)); }
    T.src = src + (size_t)k0 * Nsrc + s0; T.gain = gain ? gain + k0 : nullptr; T.dst = dst + (size_t)n0 * K + k0; T.K = K; T.Nsrc = Nsrc; T.scale = scale;
}
__device__ __forceinline__ void titem_load(const TItem& T, int lane, float (&v)[32]) {
    const float* p = T.src + (size_t)(lane >> 5) * T.Nsrc + (lane & 31);
#pragma unroll
    for (int i = 0; i < 32; ++i) v[i] = __builtin_nontemporal_load(p + (size_t)(2 * i) * T.Nsrc);
}
__device__ __forceinline__ void titem_store(const TItem& T, int lane, const float (&v)[32], LAS float* scr) {
#pragma unroll
    for (int i = 0; i < 32; ++i) scr[(2 * i + (lane >> 5)) * 33 + (lane & 31)] = v[i];
    const int c = lane & 7;
    f32x4 g0 = (f32x4){1.f, 1.f, 1.f, 1.f}, g1 = g0;
    if (T.gain) { g0 = *(const f32x4*)(T.gain + 8 * c); g1 = *(const f32x4*)(T.gain + 8 * c + 4); }
    g0 = g0 * T.scale; g1 = g1 * T.scale;
    asm volatile("s_waitcnt lgkmcnt(0)" ::: "memory");
#pragma unroll
    for (int j = 0; j < 4; ++j) { const int n = (lane >> 3) + 8 * j; const LAS float* s = scr + (8 * c) * 33 + n;
        u32x4 o; o.x = pk2(s[0 * 33] * g0[0], s[1 * 33] * g0[1]); o.y = pk2(s[2 * 33] * g0[2], s[3 * 33] * g0[3]); o.z = pk2(s[4 * 33] * g1[0], s[5 * 33] * g1[1]); o.w = pk2(s[6 * 33] * g1[2], s[7 * 33] * g1[3]);
        *(u32x4*)(T.dst + (size_t)n * T.K + 8 * c) = o; }
    asm volatile("s_waitcnt lgkmcnt(0)" ::: "memory");
}
__device__ __forceinline__ void prep_phase(const Params& P, LAS unsigned char* lds) {
    const int tid = fresh_tid(), lane = tid & 63, wave = __builtin_amdgcn_readfirstlane(tid >> 6), gw = blockIdx.x * NWAVES + wave, ngw = gridDim.x * NWAVES;
    LAS float* scr = (LAS float*)(lds + wave * 16384);
    constexpr int NITEMS = 2 * 16 * 96 + 2 * 16 * 32 + 16 * 96 + 2 * 16 * 48 + 2 * 8 * 32 + 4 * 16 * 128 + 4 * 64 * 32;
    {
        TItem cur, nxt; float v[32], vn[32]; int it = gw;
        if (it < NITEMS) { titem_decode(P, it, cur); titem_load(cur, lane, v); }
        while (it < NITEMS) {
            const int itn = it + ngw; const bool hasn = itn < NITEMS;
            if (hasn) { titem_decode(P, itn, nxt); titem_load(nxt, lane, vn); }
            titem_store(cur, lane, v, scr);
            if (hasn) { cur = nxt;
#pragma unroll
                for (int i = 0; i < 32; ++i) v[i] = vn[i]; }
            it = itn;
        }
    }
    const float* x = P.in[0]; bf16* hb = (bf16*)(P.ws + WS_HB); float* ssq = (float*)(P.ws + WS_SSQ);
    for (int m0 = gw * 4; m0 < M; m0 += ngw * 4) {
        f32x4 v[4][4];
#pragma unroll
        for (int rr = 0; rr < 4; ++rr) { const f32x4* xr = (const f32x4*)(x + (size_t)(m0 + rr) * D) + lane;
#pragma unroll
            for (int j = 0; j < 4; ++j) v[rr][j] = __builtin_nontemporal_load(xr + 64 * j); }
#pragma unroll
        for (int rr = 0; rr < 4; ++rr) { float s = 0.f;
#pragma unroll
            for (int j = 0; j < 4; ++j) s += (v[rr][j][0] * v[rr][j][0] + v[rr][j][1] * v[rr][j][1]) + (v[rr][j][2] * v[rr][j][2] + v[rr][j][3] * v[rr][j][3]);
#pragma unroll
            for (int o = 1; o < 64; o <<= 1) s += __shfl_xor(s, o);
            u32x2* o8 = (u32x2*)(hb + (size_t)(m0 + rr) * D) + lane;
#pragma unroll
            for (int j = 0; j < 4; ++j) { u32x2 w; w.x = pk2(v[rr][j][0], v[rr][j][1]); w.y = pk2(v[rr][j][2], v[rr][j][3]); o8[64 * j] = w; }
            if (lane < 16) ssq[(size_t)(m0 + rr) * 16 + lane] = (lane == 0) ? s : 0.f; }
    }
}

__device__ __forceinline__ void unpack8(const u32x4 u, float (&f)[8]) { f[0] = bflo(u.x); f[1] = bfhi(u.x); f[2] = bflo(u.y); f[3] = bfhi(u.y); f[4] = bflo(u.z); f[5] = bfhi(u.z); f[6] = bflo(u.w); f[7] = bfhi(u.w); }
__device__ __forceinline__ void conv_phase(const float* __restrict__ cw, const bf16* __restrict__ Bb, const bf16* __restrict__ CU, bf16* __restrict__ Y) {
    const int tid = fresh_tid(), lane = tid & 63, wave = __builtin_amdgcn_readfirstlane(tid >> 6), gw = blockIdx.x * NWAVES + wave, ngw = gridDim.x * NWAVES;
    constexpr int TR = 32;
    for (int ui = gw; ui < (M / TR) * 2; ui += ngw) {
        const int t0 = (ui >> 1) * TR, col = (ui & 1) * 512 + lane * 8;
        float w0[8], w1[8], w2[8], p1[8], p2[8];
#pragma unroll
        for (int j = 0; j < 8; ++j) { w0[j] = cw[col + j]; w1[j] = cw[1024 + col + j]; w2[j] = cw[2048 + col + j]; p1[j] = 0.f; p2[j] = 0.f; }
        if ((t0 & (SEQ - 1)) != 0) { unpack8(*(const u32x4*)(CU + (size_t)(t0 - 1) * 1024 + col), p1); unpack8(*(const u32x4*)(CU + (size_t)(t0 - 2) * 1024 + col), p2); }
#pragma unroll 4
        for (int t = 0; t < TR; ++t) {
            const size_t off = (size_t)(t0 + t) * 1024 + col;
            float c[8], b[8]; unpack8(*(const u32x4*)(CU + off), c); unpack8(*(const u32x4*)(Bb + off), b);
            float y[8];
#pragma unroll
            for (int j = 0; j < 8; ++j) { y[j] = b[j] * (w0[j] * c[j] + w1[j] * p1[j] + w2[j] * p2[j]); p2[j] = p1[j]; p1[j] = c[j]; }
            u32x4 w; w.x = pk2(y[0], y[1]); w.y = pk2(y[2], y[3]); w.z = pk2(y[4], y[5]); w.w = pk2(y[6], y[7]);
            *(u32x4*)(Y + off) = w;
        }
    }
}

constexpr int KROW = 144, VROW = 160, KL_BYTES = 256 * KROW;
__device__ __forceinline__ s16x4 vtr(const LAS unsigned char* p) { return __builtin_bit_cast(s16x4, __builtin_amdgcn_ds_read_tr16_b64_v4i16((LAS s16x4*)p)); }
__device__ __forceinline__ void sub_geom(int idx, int sp, int& g, int& dil, int& r, int& n) { g = idx >> 4; const int sub = idx & 15, ld = 2 * g, nb = 16 >> ld; dil = 1 << ld; r = sub >> (4 - ld); n = sp * nb + (sub & (nb - 1)); }
__device__ __forceinline__ void attn_prefetch(const bf16* __restrict__ kv, const bf16* __restrict__ q, int idx, int b, int h, int sp, int tid, int w, int fr, int fq,
                                              u32x4 (&kreg)[4], u32x4 (&vreg)[4], bf16x8 (&qreg)[2]) {
    int g, dil, r, n; sub_geom(idx, sp, g, dil, r, n);
    const int pbase = r * (SEQ >> (2 * g)) + (n - 1) * 128;
    const bf16* kp = kv + ((size_t)((b * 3 + g) * 16 + h) * SEQ + pbase) * 64;
    const bf16* vp = kp + (size_t)8 * SEQ * 64;
#pragma unroll
    for (int i = 0; i < 4; ++i) {
        const int c4 = tid + 512 * i;
        if (i >= 2 || n > 0) { kreg[i] = *(const u32x4*)(kp + c4 * 8); vreg[i] = *(const u32x4*)(vp + c4 * 8); }
        else { kreg[i] = (u32x4){0u, 0u, 0u, 0u}; vreg[i] = (u32x4){0u, 0u, 0u, 0u}; }
    }
    const bf16* qp = q + ((size_t)((b * 3 + g) * 8 + h) * SEQ + pbase + 128 + 16 * w + fr) * 64 + 8 * fq;
    qreg[0] = __builtin_nontemporal_load((const bf16x8*)qp); qreg[1] = __builtin_nontemporal_load((const bf16x8*)(qp + 32));
}
#define ATT_BAR() do { asm volatile("s_waitcnt lgkmcnt(0)" ::: "memory"); __builtin_amdgcn_s_barrier(); asm volatile("" ::: "memory"); } while (0)
__device__ __forceinline__ void attn_phase(LAS unsigned char* lds, const bf16* __restrict__ kv, const bf16* __restrict__ q, bf16* og0, bf16* og1, bf16* og2, float* lse3, int item) {
    const int tid = fresh_tid(), lane = tid & 63, w = __builtin_amdgcn_readfirstlane(tid >> 6), fr = lane & 15, fq = lane >> 4;
    const int b = item >> 4, h = (item >> 1) & 7, sp = item & 1;
    constexpr float LOG2E = 1.4426950408889634f, LN2 = 0.6931471805599453f;
    const float slope2 = exp2f(-(float)(h + 1)) * LOG2E;
    constexpr int ABUF = KL_BYTES + 256 * VROW;
    u32x4 kreg[4], vreg[4]; bf16x8 q1[2], q2[2];
    const int part = tid & 7, rbase = tid >> 3;
#define ATT_WRITE(bufsel) do { LAS unsigned char* kb_ = lds + (bufsel) * ABUF; _Pragma("unroll") for (int i = 0; i < 4; ++i) { const int row = rbase + 64 * i; \
        *(LAS u32x4*)(kb_ + row * KROW + part * 16) = kreg[i]; *(LAS u32x4*)(kb_ + KL_BYTES + row * VROW + part * 16) = vreg[i]; } } while (0)
    attn_prefetch(kv, q, 0, b, h, sp, tid, w, fr, fq, kreg, vreg, q2);
    ATT_BAR();
    ATT_WRITE(0); q1[0] = q2[0]; q1[1] = q2[1];
    attn_prefetch(kv, q, 1, b, h, sp, tid, w, fr, fq, kreg, vreg, q2);
    for (int idx = 0; idx < 48; ++idx) {
        int g, dil, r, n; sub_geom(idx, sp, g, dil, r, n);
        ATT_BAR();
        bf16x8 qf[2] = {q1[0], q1[1]};
        if (idx + 1 < 48) { ATT_WRITE((idx + 1) & 1); q1[0] = q2[0]; q1[1] = q2[1]; }
        if (idx + 2 < 48) attn_prefetch(kv, q, idx + 2, b, h, sp, tid, w, fr, fq, kreg, vreg, q2);
        LAS unsigned char* Kl = lds + (idx & 1) * ABUF; LAS unsigned char* Vl = Kl + KL_BYTES;
        f32x4 acc[9];
        const LAS unsigned char* kbase = Kl + (16 * w + fr) * KROW + fq * 16;
        bf16x8 kf[9][2];
#pragma unroll
        for (int t = 0; t < 9; ++t) { kf[t][0] = *(const LAS bf16x8*)(kbase + t * 16 * KROW); kf[t][1] = *(const LAS bf16x8*)(kbase + t * 16 * KROW + 64); }
        __builtin_amdgcn_sched_barrier(0);
#pragma unroll
        for (int t = 0; t < 9; ++t) {
            const float ci = (n == 0 && w + t < 8) ? -1.0e30f : 0.f;
            acc[t] = __builtin_amdgcn_mfma_f32_16x16x32_bf16(kf[t][0], qf[0], (f32x4){ci, ci, ci, ci}, 0, 0, 0);
        }
#pragma unroll
        for (int t = 0; t < 9; ++t) acc[t] = __builtin_amdgcn_mfma_f32_16x16x32_bf16(kf[t][1], qf[1], acc[t], 0, 0, 0);
        const float sd = slope2 * (float)dil;
        float mx4[4] = {-3.0e38f, -3.0e38f, -3.0e38f, -3.0e38f};
#pragma unroll
        for (int t = 0; t < 9; ++t)
#pragma unroll
            for (int e = 0; e < 4; ++e) {
                const int j = 128 + fr - 16 * t - 4 * fq - e;
                float s = acc[t][e] - sd * (float)j;
                bool ok = true;
                if (t == 0) ok = (j <= 128);
                if (t == 8) ok = (j >= 0);
                s = ok ? s : -INFINITY;
                acc[t][e] = s; mx4[e] = fmaxf(mx4[e], s);
            }
        float mx = quad16_max(fmaxf(fmaxf(mx4[0], mx4[1]), fmaxf(mx4[2], mx4[3])));
        float l4[4] = {0.f, 0.f, 0.f, 0.f};
#pragma unroll
        for (int t = 0; t < 9; ++t)
#pragma unroll
            for (int e = 0; e < 4; ++e) { const float p = __builtin_amdgcn_exp2f(acc[t][e] - mx); acc[t][e] = p; l4[e] += p; }
        float l = (l4[0] + l4[1]) + (l4[2] + l4[3]);
        l = quad16_sum(l);
        f32x4 o[4];
#pragma unroll
        for (int dt = 0; dt < 4; ++dt) o[dt] = (f32x4){0.f, 0.f, 0.f, 0.f};
        const LAS unsigned char* vbase = Vl + (16 * w + 4 * fq + (fr >> 2)) * VROW + (fr & 3) * 8;
#pragma unroll
        for (int kk = 0; kk < 5; ++kk) {
            const int t0 = 2 * kk, t1 = (2 * kk + 1 < 9) ? 2 * kk + 1 : 8;
            bf16x8 pf;
            { const unsigned a0 = pk2(acc[t0][0], acc[t0][1]), a1 = pk2(acc[t0][2], acc[t0][3]);
              unsigned b0 = 0u, b1 = 0u; if (2 * kk + 1 < 9) { b0 = pk2(acc[t1][0], acc[t1][1]); b1 = pk2(acc[t1][2], acc[t1][3]); }
              const u32x4 pw = (u32x4){a0, a1, b0, b1}; pf = __builtin_bit_cast(bf16x8, pw); }
#pragma unroll
            for (int dt = 0; dt < 4; ++dt) {
                const s16x4 lo = vtr(vbase + t0 * 16 * VROW + dt * 32), hi = vtr(vbase + t1 * 16 * VROW + dt * 32);
                const bf16x8 vf = (bf16x8){lo[0], lo[1], lo[2], lo[3], hi[0], hi[1], hi[2], hi[3]};
                o[dt] = __builtin_amdgcn_mfma_f32_16x16x32_bf16(vf, pf, o[dt], 0, 0, 0);
            }
        }
        const int qtok = b * SEQ + (n * 128 + 16 * w + fr) * dil + r;
        const float inv_l = 1.0f / l, lse1 = (mx + log2f(l)) * LN2;
        bf16* op = (g == 0 ? og0 : (g == 1 ? og1 : og2)) + (size_t)qtok * OD + h * 64 + 16 * (fq & 1) + 8 * (fq >> 1);
        u32x2 pk[4];
#pragma unroll
        for (int dt = 0; dt < 4; ++dt) { pk[dt].x = pk2(o[dt][0] * inv_l, o[dt][1] * inv_l); pk[dt].y = pk2(o[dt][2] * inv_l, o[dt][3] * inv_l); }
#pragma unroll
        for (int pr = 0; pr < 2; ++pr) {
            const auto rx = __builtin_amdgcn_permlane16_swap(pk[2 * pr].x, pk[2 * pr + 1].x, false, false);
            const auto ry = __builtin_amdgcn_permlane16_swap(pk[2 * pr].y, pk[2 * pr + 1].y, false, false);
            const u32x4 wv = (u32x4){(unsigned)rx[0], (unsigned)ry[0], (unsigned)rx[1], (unsigned)ry[1]};
            *(u32x4*)(op + 32 * pr) = wv; }
        if (fq == 0) lse3[(size_t)g * M * 8 + (size_t)qtok * 8 + h] = lse1;
    }
    __threadfence(); __syncthreads();
    {
        const int tok0 = b * SEQ + sp * 2048;
        const float* ls0 = lse3 + (size_t)tok0 * 8 + h; const float* ls1 = ls0 + (size_t)M * 8; const float* ls2 = ls1 + (size_t)M * 8;
        const size_t obase = (size_t)tok0 * OD + h * 64 + (tid & 7) * 8;
        for (int k0 = 0; k0 < 32; k0 += 4) {
            float lv[4][3]; u32x4 r0[4], r1[4], r2[4];
#pragma unroll
            for (int k = 0; k < 4; ++k) { const int t = (tid >> 3) + 64 * (k0 + k); lv[k][0] = ls0[t * 8]; lv[k][1] = ls1[t * 8]; lv[k][2] = ls2[t * 8];
                const size_t off = obase + (size_t)t * OD; r0[k] = __builtin_nontemporal_load((const u32x4*)(og0 + off)); r1[k] = __builtin_nontemporal_load((const u32x4*)(og1 + off)); r2[k] = __builtin_nontemporal_load((const u32x4*)(og2 + off)); }
#pragma unroll
            for (int k = 0; k < 4; ++k) { const int t = (tid >> 3) + 64 * (k0 + k); const size_t off = obase + (size_t)t * OD;
                const float mm = fmaxf(lv[k][0], fmaxf(lv[k][1], lv[k][2])); float e0 = __expf(lv[k][0] - mm), e1 = __expf(lv[k][1] - mm), e2 = __expf(lv[k][2] - mm);
                const float inv = 1.0f / (e0 + e1 + e2); e0 *= inv; e1 *= inv; e2 *= inv;
                float a0[8], a1[8], a2[8], y[8]; unpack8(r0[k], a0); unpack8(r1[k], a1); unpack8(r2[k], a2);
#pragma unroll
                for (int j = 0; j < 8; ++j) y[j] = a0[j] * e0 + a1[j] * e1 + a2[j] * e2;
                u32x4 wv; wv.x = pk2(y[0], y[1]); wv.y = pk2(y[2], y[3]); wv.z = pk2(y[4], y[5]); wv.w = pk2(y[6], y[7]);
                *(u32x4*)(og0 + off) = wv; }
        }
    }
}

__device__ __forceinline__ void final_phase(float* out, const bf16* __restrict__ hb, const float* __restrict__ gain) {
    const int tid = fresh_tid(), lane = tid & 63, wave = __builtin_amdgcn_readfirstlane(tid >> 6), gw = blockIdx.x * NWAVES + wave, ngw = gridDim.x * NWAVES;
    f32x4 gv[2][2];
#pragma unroll
    for (int j = 0; j < 2; ++j) { gv[j][0] = *(const f32x4*)(gain + 512 * j + lane * 8); gv[j][1] = *(const f32x4*)(gain + 512 * j + lane * 8 + 4); }
    for (int m = gw; m < M; m += ngw) {
        float v[2][8]; float s = 0.f;
#pragma unroll
        for (int j = 0; j < 2; ++j) { unpack8(__builtin_nontemporal_load((const u32x4*)(hb + (size_t)m * D + 512 * j + lane * 8)), v[j]);
#pragma unroll
            for (int e = 0; e < 8; ++e) s += v[j][e] * v[j][e]; }
#pragma unroll
        for (int o = 1; o < 64; o <<= 1) s += __shfl_xor(s, o);
        const float rstd = rsqrtf(s * (1.0f / 1024.0f) + 1e-5f);
#pragma unroll
        for (int j = 0; j < 2; ++j) { float* op = out + (size_t)m * D + 512 * j + lane * 8;
            __builtin_nontemporal_store((f32x4){v[j][0], v[j][1], v[j][2], v[j][3]} * rstd * gv[j][0], (f32x4*)op); __builtin_nontemporal_store((f32x4){v[j][4], v[j][5], v[j][6], v[j][7]} * rstd * gv[j][1], (f32x4*)(op + 4)); }
    }
}

#define XB_TMO      128
#define XB_XCNT(j)  (256  + 64 * (j))
#define XB_XSUB(j)  (1280 + 64 * (j))
#define XB_XGEN(j)  (2304 + 64 * (j))
#define XB_TOP      3328
#define XB_TOPGEN   3392
#define XCD_BAR_WORDS 3456
#define XB_SPIN_CAP (1u << 18)

__device__ __forceinline__ unsigned xb_ld(unsigned* p)              { return __hip_atomic_load(p, __ATOMIC_RELAXED, __HIP_MEMORY_SCOPE_AGENT); }
__device__ __forceinline__ unsigned xb_add(unsigned* p, unsigned v) { return __hip_atomic_fetch_add(p, v, __ATOMIC_RELAXED, __HIP_MEMORY_SCOPE_AGENT); }
__device__ __forceinline__ unsigned xb_xcc_id() { return (unsigned)__builtin_amdgcn_s_getreg((3 << 11) | 20) & 0xFu; }
#define XB_SPIN(cond, bar) do { unsigned _sp = 0; while (cond) { __builtin_amdgcn_s_sleep(1); \
    if ((++_sp & 255u) == 0u) { if (xb_ld(&(bar)[XB_TMO])) break; if (_sp > XB_SPIN_CAP) { atomicAdd(&(bar)[XB_TMO], 1u); break; } } } } while (0)

struct XcdBarrier {
    unsigned* bar; unsigned x;
    volatile LAS unsigned* st;
};

__device__ __forceinline__ XcdBarrier xcd_barrier_post(unsigned* bar, volatile LAS unsigned* st) {
    XcdBarrier b; b.bar = bar; b.x = xb_xcc_id(); b.st = st;
    if (threadIdx.x == 0) (void)xb_add(&bar[XB_XCNT(b.x)], 1u);
    return b;
}
__device__ __forceinline__ void xcd_barrier_complete(unsigned* bar, unsigned x, unsigned& nloc, unsigned& nx) {
    const unsigned G = gridDim.x * gridDim.y * gridDim.z;
    unsigned sum, cnt, mine, sp = 0u;
    for (;;) {
        sum = 0u; cnt = 0u; mine = 0u;
#pragma unroll
        for (unsigned j = 0; j < 16; ++j) { const unsigned c = xb_ld(&bar[XB_XCNT(j)]); sum += c; cnt += (c > 0u) ? 1u : 0u; mine = (j == x) ? c : mine; }
        if (sum == G) break;
        __builtin_amdgcn_s_sleep(1);
        if ((++sp & 255u) == 0u) { if (xb_ld(&bar[XB_TMO])) break; if (sp > XB_SPIN_CAP) { atomicAdd(&bar[XB_TMO], 1u); break; } }
    }
    nloc = mine > 0u ? mine : 1u; nx = cnt > 0u ? cnt : 1u;
}

__device__ __forceinline__ void xcd_barrier(const XcdBarrier& b) {
    asm volatile("s_waitcnt vmcnt(0)" ::: "memory");
    __syncthreads();
    if (threadIdx.x == 0) {
        unsigned* bar = b.bar;
        __builtin_amdgcn_s_waitcnt(0);
        unsigned nloc = b.st[0], nx = b.st[1];
        if (nloc == 0u) { xcd_barrier_complete(bar, b.x, nloc, nx); b.st[0] = nloc; b.st[1] = nx; }
        const unsigned old = xb_add(&bar[XB_XSUB(b.x)], 1u);
        const unsigned gen = old / nloc;
        if (old + 1u == (gen + 1u) * nloc) {
            __builtin_amdgcn_fence(__ATOMIC_RELEASE, "agent");
            asm volatile("s_waitcnt vmcnt(0)" ::: "memory");
            const unsigned og = xb_add(&bar[XB_TOP], 1u);
            const unsigned tg = og / nx;
            if (og + 1u == (tg + 1u) * nx) xb_add(&bar[XB_TOPGEN], 1u);
            else XB_SPIN(xb_ld(&bar[XB_TOPGEN]) == tg, bar);
            __builtin_amdgcn_fence(__ATOMIC_ACQUIRE, "agent");
            xb_add(&bar[XB_XGEN(b.x)], 1u);
            asm volatile("s_waitcnt vmcnt(0)" ::: "memory");
        } else {
            XB_SPIN(xb_ld(&bar[XB_XGEN(b.x)]) == gen, bar);
            __builtin_amdgcn_fence(__ATOMIC_ACQUIRE, "agent");
            asm volatile("s_waitcnt vmcnt(0)" ::: "memory");
        }
    }
    __syncthreads();
}


__global__ void __launch_bounds__(NTHREADS, 2) yoco_fwd(Params P) {
    extern __shared__ __attribute__((aligned(16))) unsigned char lds_raw[];
    LAS unsigned char* lds = (LAS unsigned char*)lds_raw;
    cg::grid_group grid = cg::this_grid();
    volatile LAS unsigned* bst = (volatile LAS unsigned*)(lds + LDS_BYTES - 64);
    if (threadIdx.x < 2) bst[threadIdx.x] = 0u;
    __syncthreads();
    if (blockIdx.x == 0) { for (int i = threadIdx.x; i < XCD_BAR_WORDS; i += NTHREADS) __hip_atomic_store((unsigned*)P.ws + i, 0u, __ATOMIC_RELAXED, __HIP_MEMORY_SCOPE_AGENT); }
    const int G = gridDim.x, bx = blockIdx.x;
    unsigned char* ws = P.ws;
    bf16* hb = (bf16*)(ws + WS_HB); float* ssq = (float*)(ws + WS_SSQ); float* ssqm = (float*)(ws + WS_SSQ2);
    bf16* bbuf = (bf16*)(ws + WS_R1); bf16* cubuf = (bf16*)(ws + WS_R1 + 128 * MiB); bf16* kvb = (bf16*)(ws + WS_R1);
    bf16* ybuf = (bf16*)(ws + WS_R2); bf16* hid = (bf16*)(ws + WS_R2); bf16* qb = (bf16*)(ws + WS_R2); bf16* ob = (bf16*)(ws + WS_R2 + 192 * MiB);
    float* out = P.out;

#ifndef SKIP_PREP
    prep_phase(P, lds);
#endif
    grid.sync();
    const XcdBarrier bar = xcd_barrier_post((unsigned*)P.ws, bst);

    for (int l = 0; l < 4; ++l) {
        if (l < 2) {
            for (int c = 0; c < M / MCA; ++c) {
                const size_t ro = (size_t)c * MCA;
                {
                    pg8::Gemm g{hb + ro * D, (const bf16*)(ws + WS_WAIN + (size_t)l * 6 * MiB) + (size_t)1024 * 1024, MCA, 2048, D}; pg8::StaticOrder S; S.init(MCA, 2048, G, bx);
                    pg8::EpiCU E{cubuf + ro * D, ssq + ro * 16};
                    GEMM_PHASE<pg8::EpiCU, pg8::StaticOrder, true, true>(lds, g, S, E);
                }
                xcd_barrier(bar);
                {
                    pg8::Gemm g{hb + ro * D, (const bf16*)(ws + WS_WAIN + (size_t)l * 6 * MiB), MCA, 1024, D}; pg8::StaticOrder S; S.init(MCA, 1024, G, bx);
                    pg8::EpiBConv E{cubuf + ro * D, ybuf + ro * D, P.in[4] + (size_t)l * 3 * 1024, ssq + ro * 16};
                    GEMM_PHASE<pg8::EpiBConv, pg8::StaticOrder, true, true>(lds, g, S, E);
                }
                xcd_barrier(bar);
                {
                    pg8::Gemm g{ybuf + ro * D, (const bf16*)(ws + WS_WAOUT + (size_t)l * 2 * MiB), MCA, D, D}; pg8::StaticOrder S; S.init(MCA, D, G, bx);
                    pg8::EpiRes E{hb + ro * D, ssqm + ro * 16, nullptr};
                    GEMM_PHASE<pg8::EpiRes, pg8::StaticOrder, true, true>(lds, g, S, E);
                }
                if (c + 1 == M / MCA) xcd_barrier(bar); else __syncthreads();
            }
        } else {
            {
                const bool first = (l == 2);
                pg8::Gemm g{hb, (const bf16*)(ws + (first ? WS_WQKV : WS_WQ3)), M, first ? NQKV : NQ, D}; pg8::StaticOrder S; S.init(M, g.N, G, bx);
                pg8::EpiQKV E{kvb, qb, first ? NKV : 0, ssq};
                GEMM_PHASE<pg8::EpiQKV, pg8::StaticOrder, true, true>(lds, g, S, E);
            }
            xcd_barrier(bar);
#ifndef SKIP_ATTN
            for (int item = bx; item < 256; item += G) attn_phase(lds, kvb, qb, ob, (bf16*)(ws + WS_OG1), (bf16*)(ws + WS_OG2), (float*)(ws + WS_LSE3), item);
#endif
            xcd_barrier(bar);
            {
                pg8::Gemm g{ob, (const bf16*)(ws + WS_WO + (size_t)(l - 2) * MiB), M, D, OD}; pg8::StaticOrder S; S.init(M, D, G, bx);
                pg8::EpiRes E{hb, ssqm, nullptr};
                GEMM_PHASE<pg8::EpiRes, pg8::StaticOrder, true, true>(lds, g, S, E);
            }
            xcd_barrier(bar);
        }
        for (int c = 0; c < M / MCH; ++c) {
            const size_t ro = (size_t)(M / MCH - 1 - c) * MCH; bf16* hidc = hid + (size_t)(c & 1) * MCH * FF;
            {
                pg8::Gemm g{hb + ro * D, (const bf16*)(ws + WS_WUP + (size_t)l * 8 * MiB), MCH, FF, D}; pg8::StaticOrder S; S.init(MCH, FF, G, bx);
                pg8::EpiScaleBf16<1> E{hidc, FF, hidc, FF, 1 << 30, nullptr};
                GEMM_PHASE<pg8::EpiScaleBf16<1>, pg8::StaticOrder, true, true>(lds, g, S, E);
            }
            xcd_barrier(bar);
            {
                pg8::Gemm g{hidc, (const bf16*)(ws + WS_WDN + (size_t)l * 8 * MiB), MCH, D, FF}; pg8::StaticOrder S; S.init(MCH, D, G, bx);
                pg8::EpiRes E{hb + ro * D, ssq + ro * 16, ssqm + ro * 16};
                GEMM_PHASE<pg8::EpiRes, pg8::StaticOrder, true, true>(lds, g, S, E);
            }
            if (c + 1 == M / MCH) xcd_barrier(bar); else __syncthreads();
        }
    }
#ifndef SKIP_FINAL
    final_phase(out, hb, P.in[12]);
#endif
}

extern "C" void kernel_launch(void* const* d_in, const int* in_sizes, int n_in, void* d_out, int out_size, void* d_ws, size_t ws_size, hipStream_t stream) {
    static int grid = 0;
    if (grid == 0) {
        if (n_in != 13 || out_size != M * D || ws_size < WS_END) { fprintf(stderr, "kernel_launch: unexpected shapes (n_in %d out %d ws %zu)\n", n_in, out_size, ws_size); grid = -1; return; }
        int dev = 0, cus = 0, per_cu = 0;
        hipGetDevice(&dev); hipDeviceGetAttribute(&cus, hipDeviceAttributeMultiprocessorCount, dev);
        if (hipFuncSetAttribute((const void*)yoco_fwd, hipFuncAttributeMaxDynamicSharedMemorySize, LDS_BYTES) != hipSuccess) { fprintf(stderr, "kernel_launch: hipFuncSetAttribute failed\n"); grid = -1; return; }
        if (hipOccupancyMaxActiveBlocksPerMultiprocessor(&per_cu, (const void*)yoco_fwd, NTHREADS, LDS_BYTES) != hipSuccess || per_cu < 1) { fprintf(stderr, "kernel_launch: occupancy query says %d\n", per_cu); per_cu = 1; }
        (void)hipGetLastError();
        grid = cus;
        if (grid != 256) fprintf(stderr, "kernel_launch: %d CUs (expected 256)\n", grid);
    }
    if (grid < 0) return;
    Params p{};
    for (int i = 0; i < 13; ++i) p.in[i] = (const float*)d_in[i];
    p.out = (float*)d_out; p.ws = (unsigned char*)d_ws;
    void* args[] = {&p};
    hipError_t e = hipLaunchCooperativeKernel((const void*)yoco_fwd, dim3(grid), dim3(NTHREADS), args, LDS_BYTES, stream);
    if (e != hipSuccess) fprintf(stderr, "kernel_launch: cooperative launch failed: %s (grid %d)\n", hipGetErrorString(e), grid);
}
```

```cpp
#include <hip/hip_runtime.h>
#include <hip/hip_cooperative_groups.h>
#include <cstdio>
#include <cstdint>
namespace cg = cooperative_groups;
namespace pg8 {
#define PG8_LAS __attribute__((address_space(3)))
typedef unsigned short bf16_t;
typedef short bf16x8 __attribute__((ext_vector_type(8)));
typedef float f32x4 __attribute__((ext_vector_type(4)));
typedef unsigned u32x4 __attribute__((ext_vector_type(4)));
constexpr int BM = 256, BK = 64, HALF = 128, HTB = HALF * BK * 2  , STAGE_BYTES = 8 * HTB, NXCD = 8, WGM = 8;

__host__ __device__ __forceinline__ int lds_byte(int r, int c) { const int st = (r >> 4) * 2 + (c >> 5), rr = r & 15, cc = c & 31, ob = rr * 64 + cc * 2; return st * 1024 + (ob ^ (((ob >> 9) & 1) << 5)); }
__host__ __device__ __forceinline__ void stage_rc(int b, int& R, int& C) { const int st = b / 1024, sb = b % 1024, swz = sb ^ (((sb >> 9) & 1) << 5); R = (st >> 1) * 16 + swz / 64; C = (st & 1) * 32 + (swz % 64) / 2; }
__host__ __device__ __forceinline__ int perm32(int rho) { const int n = rho >> 4, i = rho & 15; return 8 * (i >> 2) + 4 * n + (i & 3); }

struct Unit { int pm, pn; };
struct Gemm { const bf16_t* A; const bf16_t* Bt; int M, N, K; };

struct StaticOrder {
    int nM, nN, nwg, G, c;
    __host__ __device__ void init(int M, int N, int G_, int c_) { nM = M / BM; nN = N / BM; nwg = nM * nN; G = G_; c = c_; }
    __host__ __device__ bool next(int i, Unit& u) const {
        const long L = (long)i * G + c; if (L >= nwg) return false;
        int wgid = (int)L; { const int q = nwg / NXCD, r = nwg % NXCD, xcd = wgid % NXCD, off = wgid / NXCD; wgid = (xcd < r ? xcd * (q + 1) : r * (q + 1) + (xcd - r) * q) + off; }
        const int nig = WGM * nN, gid = wgid / nig, fm = gid * WGM, gsz = (nM - fm) < WGM ? (nM - fm) : WGM;
        u.pm = fm + ((wgid % nig) % gsz); u.pn = (wgid % nig) / gsz; return true;
    }
    __device__ __forceinline__ void a_ready(const Unit&) const {}
    __device__ __forceinline__ void done(const Unit&) const {}
};

__device__ __forceinline__ unsigned cvt_pk_bf16(float lo, float hi) { unsigned r; asm volatile("v_cvt_pk_bf16_f32 %0, %1, %2" : "=v"(r) : "v"(lo), "v"(hi)); return r; }

template <class Epi, class Sched, bool ALIGN_EPI = false, bool SP2 = false>
__device__ __forceinline__ void gemm_phase(PG8_LAS unsigned char* lds, const Gemm g, const Sched& S, const Epi& E) {
    int tid_ = threadIdx.x; asm volatile("" : "+v"(tid_));
    const int tid = tid_, wid = __builtin_amdgcn_readfirstlane(tid >> 6), lane = tid & 63, wr = wid >> 2, wc = wid & 3, fr = lane & 15, fq = lane >> 4;
    const int K = g.K, nt = K / BK;
    unsigned voffA[2], voffB[2];
#pragma unroll
    for (int i = 0; i < 2; ++i) { int R, C; stage_rc(tid * 16 + i * 8192, R, C); const int Rb = Epi::PERM ? ((R & ~31) + perm32(R & 31)) : R;
        voffA[i] = (unsigned)(R * K + C) * 2u; voffB[i] = (unsigned)(Rb * K + C) * 2u; }
    const size_t kstep = (size_t)(BK * 2);
    const size_t hstep = (size_t)HALF * K * 2;
    const size_t tstep = 2 * hstep;
    const unsigned ldsw = (unsigned)wid * 1024u;
    const int aoff = lds_byte(wr * 64 + fr, fq * 8), boff = lds_byte(wc * 32 + fr, fq * 8);
#define PG8_SA(b, h) (((b) * 2 + (h)) * HTB)
#define PG8_SB(b, h) ((4 + (b) * 2 + (h)) * HTB)
#define PG8_STAGE(bufoff, gbase, voff) do { _Pragma("unroll") for (int _i = 0; _i < 2; ++_i) \
        __builtin_amdgcn_global_load_lds((const unsigned*)((const char*)(gbase) + (voff)[_i]), (PG8_LAS unsigned*)(lds + (bufoff) + ldsw + _i * 8192), 16, 0, 0); } while (0)
#define PG8_LDA(dst, b, h) do { _Pragma("unroll") for (int m = 0; m < 4; ++m) _Pragma("unroll") for (int k = 0; k < 2; ++k) dst[m][k] = *(const PG8_LAS bf16x8*)(lds + PG8_SA(b, h) + aoff + m * 2048 + k * 1024); } while (0)
#define PG8_LDB(dst, b, h) do { _Pragma("unroll") for (int n = 0; n < 2; ++n) _Pragma("unroll") for (int k = 0; k < 2; ++k) dst[n][k] = *(const PG8_LAS bf16x8*)(lds + PG8_SB(b, h) + boff + n * 2048 + k * 1024); } while (0)
#define PG8_MMA(ai, bj, At, Bt) do { __builtin_amdgcn_s_setprio(1); _Pragma("unroll") for (int m = 0; m < 4; ++m) _Pragma("unroll") for (int n = 0; n < 2; ++n) _Pragma("unroll") for (int k = 0; k < 2; ++k) \
        acc[ai][bj][m][n] = __builtin_amdgcn_mfma_f32_16x16x32_bf16(Bt[n][k], At[m][k], acc[ai][bj][m][n], 0, 0, 0); __builtin_amdgcn_s_setprio(0); } while (0)
#define PG8_WAIT_V(n) asm volatile("s_waitcnt vmcnt(" #n ")" ::: "memory")
#define PG8_WAIT_L(n) asm volatile("s_waitcnt lgkmcnt(" #n ")" ::: "memory")
#define PG8_BAR __builtin_amdgcn_s_barrier()
#define PG8_SCHED __builtin_amdgcn_sched_barrier(0)
    Unit cur, nxt; int ui = 0;
    if (!S.next(0, cur)) return;
    f32x4 acc[2][2][4][2];
#pragma unroll
    for (int a = 0; a < 2; ++a)
#pragma unroll
        for (int b = 0; b < 2; ++b)
#pragma unroll
            for (int m = 0; m < 4; ++m)
#pragma unroll
                for (int n = 0; n < 2; ++n) acc[a][b][m][n] = (f32x4){0.f, 0.f, 0.f, 0.f};
    bf16x8 At[4][2], B0[2][2], B1[2][2];
    const char* cA = (const char*)g.A + (size_t)cur.pm * tstep; const char* cB = (const char*)g.Bt + (size_t)cur.pn * tstep;
    S.a_ready(cur);
    if constexpr (SP2) {
        PG8_STAGE(PG8_SB(0, 0), cB, voffB); PG8_STAGE(PG8_SB(0, 1), cB + hstep, voffB); PG8_STAGE(PG8_SA(0, 0), cA, voffA); PG8_STAGE(PG8_SA(0, 1), cA + hstep, voffA);
        if (wr == 1) PG8_BAR;
        PG8_WAIT_V(2); PG8_BAR;
        PG8_STAGE(PG8_SB(1, 0), cB + kstep, voffB); PG8_STAGE(PG8_SA(1, 0), cA + kstep, voffA); PG8_STAGE(PG8_SB(1, 1), cB + hstep + kstep, voffB);
        PG8_WAIT_V(6); PG8_BAR;
    } else {
        PG8_STAGE(PG8_SB(0, 0), cB, voffB); PG8_STAGE(PG8_SA(0, 0), cA, voffA); PG8_STAGE(PG8_SB(0, 1), cB + hstep, voffB); PG8_STAGE(PG8_SA(0, 1), cA + hstep, voffA);
        if (wr == 1) PG8_BAR;
        PG8_WAIT_V(4); PG8_BAR;
        PG8_STAGE(PG8_SB(1, 0), cB + kstep, voffB); PG8_STAGE(PG8_SA(1, 0), cA + kstep, voffA); PG8_STAGE(PG8_SB(1, 1), cB + hstep + kstep, voffB);
        PG8_WAIT_V(6); PG8_BAR;
    }
    for (;;) {
        const bool has_next = S.next(ui + 1, nxt);
        const char* nA = has_next ? (const char*)g.A + (size_t)nxt.pm * tstep : cA; const char* nB = has_next ? (const char*)g.Bt + (size_t)nxt.pn * tstep : cB;
        for (int t = 0; t < nt; t += 2) {
            const bool last = (t == nt - 2);
            const char* a1 = cA + (size_t)(t + 1) * kstep;
            const char* a2 = last ? nA : cA + (size_t)(t + 2) * kstep; const char* b2 = last ? nB : cB + (size_t)(t + 2) * kstep;
            const char* a3 = a2 + kstep; const char* b3 = b2 + kstep;
            if (last && has_next) S.a_ready(nxt);
            if constexpr (SP2) {
            PG8_LDB(B0, 0, 0); PG8_LDB(B1, 0, 1); PG8_SCHED; PG8_LDA(At, 0, 0); PG8_STAGE(PG8_SA(1, 1), a1 + hstep, voffA);
            PG8_WAIT_V(8); PG8_WAIT_L(0); PG8_BAR; PG8_MMA(0, 0, At, B0); PG8_MMA(0, 1, At, B1); PG8_BAR; PG8_SCHED;
            PG8_LDA(At, 0, 1); PG8_STAGE(PG8_SB(0, 0), b2, voffB); PG8_STAGE(PG8_SB(0, 1), b2 + hstep, voffB); PG8_STAGE(PG8_SA(0, 0), a2, voffA);
            PG8_WAIT_V(8); PG8_WAIT_L(0); PG8_BAR; PG8_MMA(1, 0, At, B0); PG8_MMA(1, 1, At, B1); PG8_BAR; PG8_SCHED;
            PG8_LDB(B0, 1, 0); PG8_LDB(B1, 1, 1); PG8_SCHED; PG8_LDA(At, 1, 0); PG8_STAGE(PG8_SA(0, 1), a2 + hstep, voffA);
            PG8_WAIT_V(8); PG8_WAIT_L(0); PG8_BAR; PG8_MMA(0, 0, At, B0); PG8_MMA(0, 1, At, B1); PG8_BAR; PG8_SCHED;
            PG8_LDA(At, 1, 1); PG8_STAGE(PG8_SB(1, 0), b3, voffB); PG8_STAGE(PG8_SB(1, 1), b3 + hstep, voffB); PG8_STAGE(PG8_SA(1, 0), a3, voffA);
            PG8_WAIT_V(8); PG8_WAIT_L(0); PG8_BAR; PG8_MMA(1, 0, At, B0); PG8_MMA(1, 1, At, B1); PG8_BAR; PG8_SCHED;
            } else {
            PG8_LDB(B0, 0, 0); PG8_SCHED; PG8_LDA(At, 0, 0); PG8_STAGE(PG8_SA(1, 1), a1 + hstep, voffA);
            PG8_WAIT_L(8); PG8_BAR; PG8_WAIT_L(0); PG8_MMA(0, 0, At, B0); PG8_BAR; PG8_SCHED;
            PG8_LDB(B1, 0, 1); PG8_STAGE(PG8_SB(0, 0), b2, voffB);
            PG8_BAR; PG8_WAIT_L(0); PG8_MMA(0, 1, At, B1); PG8_BAR;
            PG8_LDA(At, 0, 1); PG8_STAGE(PG8_SA(0, 0), a2, voffA);
            PG8_BAR; PG8_WAIT_L(0); PG8_MMA(1, 0, At, B0); PG8_BAR; PG8_SCHED;
            PG8_STAGE(PG8_SB(0, 1), b2 + hstep, voffB);
            PG8_WAIT_V(6); PG8_BAR; PG8_MMA(1, 1, At, B1); PG8_BAR;
            PG8_LDB(B0, 1, 0); PG8_SCHED; PG8_LDA(At, 1, 0); PG8_STAGE(PG8_SA(0, 1), a2 + hstep, voffA);
            PG8_WAIT_L(8); PG8_BAR; PG8_WAIT_L(0); PG8_MMA(0, 0, At, B0); PG8_BAR; PG8_SCHED;
            PG8_LDB(B1, 1, 1); PG8_STAGE(PG8_SB(1, 0), b3, voffB);
            PG8_BAR; PG8_WAIT_L(0); PG8_MMA(0, 1, At, B1); PG8_BAR;
            PG8_LDA(At, 1, 1); PG8_STAGE(PG8_SA(1, 0), a3, voffA);
            PG8_BAR; PG8_WAIT_L(0); PG8_MMA(1, 0, At, B0); PG8_BAR; PG8_SCHED;
            PG8_STAGE(PG8_SB(1, 1), b3 + hstep, voffB);
            PG8_WAIT_V(6); PG8_BAR; PG8_MMA(1, 1, At, B1); PG8_BAR;
            }
        }
        if constexpr (ALIGN_EPI) { if (wr == 0) PG8_BAR; }
        if constexpr (!Epi::AFTER_DRAIN) { E(acc, cur, wr, wc, fr, fq); S.done(cur); }
        if (!has_next) break;
#pragma unroll
        for (int a = 0; a < 2; ++a)
#pragma unroll
            for (int b = 0; b < 2; ++b)
#pragma unroll
                for (int m = 0; m < 4; ++m)
#pragma unroll
                    for (int n = 0; n < 2; ++n) acc[a][b][m][n] = (f32x4){0.f, 0.f, 0.f, 0.f};
        cur = nxt; cA = nA; cB = nB; ++ui;
        if constexpr (ALIGN_EPI) { if (wr == 1) PG8_BAR; }
    }
    PG8_WAIT_V(0);
    if constexpr (!ALIGN_EPI) { if (wr == 0) PG8_BAR; }
    PG8_BAR;
    if constexpr (Epi::AFTER_DRAIN) { E.fused(acc, cur, wr, wc, fr, fq, lds, wid, lane); S.done(cur); }
#undef PG8_SA
#undef PG8_SB
#undef PG8_STAGE
#undef PG8_LDA
#undef PG8_LDB
#undef PG8_MMA
#undef PG8_WAIT_V
#undef PG8_WAIT_L
#undef PG8_BAR
#undef PG8_SCHED
}
}

#define LAS __attribute__((address_space(3)))
typedef unsigned short bf16;
typedef float f32x4 __attribute__((ext_vector_type(4)));
typedef short bf16x8 __attribute__((ext_vector_type(8)));
typedef short s16x4 __attribute__((ext_vector_type(4)));
typedef unsigned u32x4 __attribute__((ext_vector_type(4)));
typedef unsigned u32x2 __attribute__((ext_vector_type(2)));
constexpr int NBATCH = 16, SEQ = 4096, D = 1024, FF = 4096, M = NBATCH * SEQ;
constexpr int NQ = 1536, NKV = 3072, NQKV = NKV + NQ, OD = 512;
constexpr int MCH = 16384, MCA = 32768;
constexpr size_t MiB = 1u << 20;
constexpr size_t WS_WAIN = 1 * MiB, WS_WAOUT = 13 * MiB, WS_WQKV = 17 * MiB, WS_WQ3 = 26 * MiB, WS_WO = 29 * MiB, WS_WUP = 31 * MiB, WS_WDN = 63 * MiB;
constexpr size_t WS_SSQ = 95 * MiB, WS_LSE = 99 * MiB, WS_HB = 102 * MiB, WS_R1 = 230 * MiB, WS_R2 = 614 * MiB, WS_OG1 = 870 * MiB, WS_OG2 = 934 * MiB, WS_LSE3 = 998 * MiB, WS_SSQ2 = 1004 * MiB, WS_END = 1008 * MiB;
constexpr int LDS_BYTES = 163840;
constexpr int NTHREADS = 512, NWAVES = 8;

__device__ __forceinline__ int fresh_tid() { int t = threadIdx.x; asm volatile("" : "+v"(t)); return t; }
__device__ __forceinline__ unsigned pk2(float lo, float hi) { return pg8::cvt_pk_bf16(lo, hi); }
__device__ __forceinline__ float bflo(unsigned u) { return __uint_as_float(u << 16); }
__device__ __forceinline__ float bfhi(unsigned u) { return __uint_as_float(u & 0xffff0000u); }
__device__ __forceinline__ float quad16_sum(float x) {
    const auto s = __builtin_amdgcn_permlane16_swap(__float_as_uint(x), __float_as_uint(x), false, false); x = __uint_as_float(s[0]) + __uint_as_float(s[1]);
    const auto t = __builtin_amdgcn_permlane32_swap(__float_as_uint(x), __float_as_uint(x), false, false); return __uint_as_float(t[0]) + __uint_as_float(t[1]); }
__device__ __forceinline__ float quad16_max(float x) {
    const auto s = __builtin_amdgcn_permlane16_swap(__float_as_uint(x), __float_as_uint(x), false, false); x = fmaxf(__uint_as_float(s[0]), __uint_as_float(s[1]));
    const auto t = __builtin_amdgcn_permlane32_swap(__float_as_uint(x), __float_as_uint(x), false, false); return fmaxf(__uint_as_float(t[0]), __uint_as_float(t[1])); }

namespace pg8 {
__device__ __forceinline__ void row_rstd(const float* ssq, int row0, int fq, float (&rs)[2][4]) {
#pragma unroll
    for (int ai = 0; ai < 2; ++ai)
#pragma unroll
        for (int m = 0; m < 4; ++m) {
            const f32x4 v = *(const f32x4*)(ssq + (size_t)(row0 + ai * HALF + m * 16) * 16 + 4 * fq);
            float s = (v[0] + v[1]) + (v[2] + v[3]);
            s += __shfl_xor(s, 16); s += __shfl_xor(s, 32);
            rs[ai][m] = rsqrtf(s * (1.0f / 1024.0f) + 1e-5f);
        }
}
__device__ __forceinline__ void row_r2(const float* ssq, int row0, int fq, float (&rs)[2][4]) {
#pragma unroll
    for (int ai = 0; ai < 2; ++ai)
#pragma unroll
        for (int m = 0; m < 4; ++m) {
            const f32x4 v = *(const f32x4*)(ssq + (size_t)(row0 + ai * HALF + m * 16) * 16 + 4 * fq);
            float s = (v[0] + v[1]) + (v[2] + v[3]);
            s += __shfl_xor(s, 16); s += __shfl_xor(s, 32);
            rs[ai][m] = 1.0f / (s * (1.0f / 1024.0f) + 1e-5f);
        }
}
template <int ACT> struct EpiScaleBf16 {
    static constexpr bool PERM = true, AFTER_DRAIN = false;
    bf16_t* O0; int ldc0; bf16_t* O1; int ldc1; int split; const float* ssq;
    __device__ __forceinline__ void operator()(const f32x4 (&acc)[2][2][4][2], const Unit& u, int wr, int wc, int fr, int fq) const {
        const int row0 = u.pm * BM + wr * 64 + fr; int colt = u.pn * BM; bf16_t* base = O0; int ldc = ldc0;
        if (colt >= split) { base = O1; ldc = ldc1; colt -= split; }
        const int col0 = colt + wc * 32 + 8 * fq;
        float rs[2][4];
        if (ACT == 1) {
#pragma unroll
            for (int i = 0; i < 8; ++i) rs[i >> 2][i & 3] = 1.0f;
        } else row_rstd(ssq, row0, fq, rs);
#pragma unroll
        for (int ai = 0; ai < 2; ++ai)
#pragma unroll
            for (int m = 0; m < 4; ++m) { bf16_t* rowp = base + (size_t)(row0 + ai * HALF + m * 16) * ldc + col0; const float r = rs[ai][m];
#pragma unroll
                for (int bj = 0; bj < 2; ++bj) { f32x4 v0 = acc[ai][bj][m][0] * r, v1 = acc[ai][bj][m][1] * r;
                    if (ACT == 1) {
#pragma unroll
                        for (int j = 0; j < 4; ++j) { const float a = fmaxf(v0[j], 0.f), b = fmaxf(v1[j], 0.f); v0[j] = a * a; v1[j] = b * b; } }
                    u32x4 w; w.x = cvt_pk_bf16(v0[0], v0[1]); w.y = cvt_pk_bf16(v0[2], v0[3]); w.z = cvt_pk_bf16(v1[0], v1[1]); w.w = cvt_pk_bf16(v1[2], v1[3]);
                    *(u32x4*)(rowp + bj * HALF) = w; } }
    }
};
struct EpiQKV {
    static constexpr bool PERM = true, AFTER_DRAIN = false;
    bf16_t* KV; bf16_t* Q; int nkv; const float* ssq;
    __device__ __forceinline__ void operator()(const f32x4 (&acc)[2][2][4][2], const Unit& u, int wr, int wc, int fr, int fq) const {
        const int row0 = u.pm * BM + wr * 64 + fr; const int colt = u.pn * BM;
        float rs[2][4]; row_rstd(ssq, row0, fq, rs);
        int g, h0; size_t plane0; bf16_t* base; int bstride;
        if (colt < nkv) { g = colt >> 10; h0 = (colt >> 6) & 7; plane0 = (size_t)(g * 2 + ((colt >> 9) & 1)) * 8; bstride = 48; base = KV; }
        else { const int cq = colt - nkv; g = cq >> 9; h0 = (cq >> 6) & 7; plane0 = (size_t)g * 8; bstride = 24; base = Q; }
        const int ld = 2 * g, dmask = (1 << ld) - 1, sh = 12 - ld;
        const int d0 = (wc & 1) * 32 + 8 * fq;
#pragma unroll
        for (int ai = 0; ai < 2; ++ai)
#pragma unroll
            for (int m = 0; m < 4; ++m) { const int row = row0 + ai * HALF + m * 16, b = row >> 12, pos = row & 4095, pp = ((pos & dmask) << sh) + (pos >> ld); const float r = rs[ai][m];
#pragma unroll
                for (int bj = 0; bj < 2; ++bj) { const f32x4 v0 = acc[ai][bj][m][0] * r, v1 = acc[ai][bj][m][1] * r;
                    const int h = h0 + 2 * bj + (wc >> 1);
                    u32x4 w; w.x = cvt_pk_bf16(v0[0], v0[1]); w.y = cvt_pk_bf16(v0[2], v0[3]); w.z = cvt_pk_bf16(v1[0], v1[1]); w.w = cvt_pk_bf16(v1[2], v1[3]);
                    *(u32x4*)(base + ((plane0 + (size_t)b * bstride + h) * 4096 + pp) * 64 + d0) = w; } }
    }
};
struct EpiCU {
    static constexpr bool PERM = true, AFTER_DRAIN = false;
    bf16_t* CU; const float* ssq;
    __device__ __forceinline__ void operator()(const f32x4 (&acc)[2][2][4][2], const Unit& u, int wr, int wc, int fr, int fq) const {
        const int row0 = u.pm * BM + wr * 64 + fr, col0 = u.pn * HALF + wc * 32 + 8 * fq;
        float rs[2][4]; row_rstd(ssq, row0, fq, rs);
#pragma unroll
        for (int ai = 0; ai < 2; ++ai)
#pragma unroll
            for (int m = 0; m < 4; ++m) { bf16_t* rowp = CU + (size_t)(row0 + ai * HALF + m * 16) * 1024 + col0; const float r2 = rs[ai][m] * rs[ai][m];
                const f32x4 v0 = acc[ai][0][m][0] * acc[ai][1][m][0] * r2, v1 = acc[ai][0][m][1] * acc[ai][1][m][1] * r2;
                u32x4 w; w.x = cvt_pk_bf16(v0[0], v0[1]); w.y = cvt_pk_bf16(v0[2], v0[3]); w.z = cvt_pk_bf16(v1[0], v1[1]); w.w = cvt_pk_bf16(v1[2], v1[3]);
                *(u32x4*)rowp = w; }
    }
};
struct EpiBConv {
    static constexpr bool PERM = true, AFTER_DRAIN = false;
    const bf16_t* CU; bf16_t* Y; const float* cw; const float* ssq;
    __device__ __forceinline__ void operator()(const f32x4 (&acc)[2][2][4][2], const Unit& u, int wr, int wc, int fr, int fq) const {
        const int row0 = u.pm * BM + wr * 64 + fr, col0 = u.pn * BM + wc * 32 + 8 * fq;
        float rs[2][4]; row_rstd(ssq, row0, fq, rs);
#pragma unroll
        for (int bj = 0; bj < 2; ++bj) {
            const int col = col0 + bj * HALF;
            f32x4 w0[2], w1[2], w2[2];
#pragma unroll
            for (int n = 0; n < 2; ++n) { w0[n] = *(const f32x4*)(cw + col + 4 * n); w1[n] = *(const f32x4*)(cw + 1024 + col + 4 * n); w2[n] = *(const f32x4*)(cw + 2048 + col + 4 * n); }
#pragma unroll
            for (int ai = 0; ai < 2; ++ai)
#pragma unroll
                for (int m = 0; m < 4; ++m) { const int row = row0 + ai * HALF + m * 16, t = row & 4095; const float r = rs[ai][m];
                    const bf16_t* cp = CU + (size_t)row * 1024 + col;
                    const u32x4 c0 = *(const u32x4*)cp; u32x4 c1 = *(const u32x4*)(cp - (t >= 1 ? 1024 : 0)), c2 = *(const u32x4*)(cp - (t >= 2 ? 2048 : 0));
                    if (t < 1) c1 = (u32x4){0u, 0u, 0u, 0u};
                    if (t < 2) c2 = (u32x4){0u, 0u, 0u, 0u};
                    const unsigned a0[4] = {c0.x, c0.y, c0.z, c0.w}, a1[4] = {c1.x, c1.y, c1.z, c1.w}, a2[4] = {c2.x, c2.y, c2.z, c2.w};
                    float y[8];
#pragma unroll
                    for (int e = 0; e < 4; ++e) { const int n = e >> 1, k = 2 * (e & 1);
                        const float lo = w0[n][k] * __uint_as_float(a0[e] << 16) + w1[n][k] * __uint_as_float(a1[e] << 16) + w2[n][k] * __uint_as_float(a2[e] << 16);
                        const float hi = w0[n][k + 1] * __uint_as_float(a0[e] & 0xffff0000u) + w1[n][k + 1] * __uint_as_float(a1[e] & 0xffff0000u) + w2[n][k + 1] * __uint_as_float(a2[e] & 0xffff0000u);
                        y[2 * e] = acc[ai][bj][m][n][k] * r * lo; y[2 * e + 1] = acc[ai][bj][m][n][k + 1] * r * hi; }
                    u32x4 w; w.x = cvt_pk_bf16(y[0], y[1]); w.y = cvt_pk_bf16(y[2], y[3]); w.z = cvt_pk_bf16(y[4], y[5]); w.w = cvt_pk_bf16(y[6], y[7]);
                    *(u32x4*)(Y + (size_t)row * 1024 + col) = w; }
        }
    }
};
struct EpiRes {
    static constexpr bool PERM = true, AFTER_DRAIN = false;
    bf16_t* hb; float* ssq; const float* ssq_scale;
    __device__ __forceinline__ void operator()(const f32x4 (&acc)[2][2][4][2], const Unit& u, int wr, int wc, int fr, int fq) const {
        const int row0 = u.pm * BM + wr * 64 + fr, col0 = u.pn * BM + wc * 32 + 8 * fq;
        float r2[2][4];
        if (ssq_scale) row_r2(ssq_scale, row0, fq, r2);
        else {
#pragma unroll
            for (int i = 0; i < 8; ++i) r2[i >> 2][i & 3] = 1.0f; }
#pragma unroll
        for (int ai = 0; ai < 2; ++ai) {
            u32x4 bs[4][2];
#pragma unroll
            for (int m = 0; m < 4; ++m)
#pragma unroll
                for (int bj = 0; bj < 2; ++bj) bs[m][bj] = *(const u32x4*)(hb + (size_t)(row0 + ai * HALF + m * 16) * 1024 + col0 + bj * HALF);
#pragma unroll
            for (int m = 0; m < 4; ++m) { const int row = row0 + ai * HALF + m * 16; bf16_t* rowp = hb + (size_t)row * 1024 + col0; float s = 0.f;
#pragma unroll
                for (int bj = 0; bj < 2; ++bj) { const u32x4 b = bs[m][bj]; const f32x4 a0 = acc[ai][bj][m][0] * r2[ai][m], a1 = acc[ai][bj][m][1] * r2[ai][m];
                    const float o0 = __uint_as_float(b.x << 16) + a0[0], o1 = __uint_as_float(b.x & 0xffff0000u) + a0[1], o2 = __uint_as_float(b.y << 16) + a0[2], o3 = __uint_as_float(b.y & 0xffff0000u) + a0[3];
                    const float o4 = __uint_as_float(b.z << 16) + a1[0], o5 = __uint_as_float(b.z & 0xffff0000u) + a1[1], o6 = __uint_as_float(b.w << 16) + a1[2], o7 = __uint_as_float(b.w & 0xffff0000u) + a1[3];
                    s += ((o0 * o0 + o1 * o1) + (o2 * o2 + o3 * o3)) + ((o4 * o4 + o5 * o5) + (o6 * o6 + o7 * o7));
                    u32x4 w; w.x = cvt_pk_bf16(o0, o1); w.y = cvt_pk_bf16(o2, o3); w.z = cvt_pk_bf16(o4, o5); w.w = cvt_pk_bf16(o6, o7);
                    *(u32x4*)(rowp + bj * HALF) = w; }
                s += __shfl_xor(s, 16); s += __shfl_xor(s, 32);
                if (fq == 0) ssq[(size_t)row * 16 + u.pn * 4 + wc] = s; }
            asm volatile("" ::: "memory"); }
    }
};
}

#ifdef SKIP_GEMM
#define GEMM_PHASE(...) (void)
template <class A, class B, bool C, bool D2, class... T> __device__ __forceinline__ void gemm_skip(T...) {}
#undef GEMM_PHASE
#define GEMM_PHASE gemm_skip
#else
#define GEMM_PHASE pg8::gemm_phase
#endif
struct Params { const float* in[13]; float* out; unsigned char* ws; };

struct TItem { const float* src; const float* gain; bf16* dst; int K, Nsrc; float scale; };
__device__ __forceinline__ void titem_decode(const Params& P, int it, TItem& T) {
    unsigned char* ws = P.ws;
    constexpr int I_AIN = 16 * 96, I_AOUT = 16 * 32, I_KV = 16 * 96, I_Q = 16 * 48, I_O = 8 * 32, I_UP = 16 * 128, I_DN = 64 * 32;
    int r = it; const float* src; const float* gain; bf16* dst; int K, Nsrc, ncols, mode = 0; float scale = 1.0f;
    if (r < 2 * I_AIN) { const int l = r / I_AIN; r -= l * I_AIN; src = P.in[3] + (size_t)l * 1024 * 3072; gain = P.in[1] + l * 1024; dst = (bf16*)(ws + WS_WAIN + (size_t)l * 6 * MiB); K = 1024; Nsrc = 3072; ncols = 3072; mode = 1; }
    else if ((r -= 2 * I_AIN) < 2 * I_AOUT) { const int l = r / I_AOUT; r -= l * I_AOUT; src = P.in[5] + (size_t)l * 1024 * 1024; gain = nullptr; dst = (bf16*)(ws + WS_WAOUT + (size_t)l * 2 * MiB); K = 1024; Nsrc = 1024; ncols = 1024; }
    else if ((r -= 2 * I_AOUT) < I_KV) { src = P.in[7]; gain = P.in[6]; dst = (bf16*)(ws + WS_WQKV); K = 1024; Nsrc = 3072; ncols = 3072; }
    else if ((r -= I_KV) < I_Q) { src = P.in[8]; gain = P.in[1] + 2 * 1024; dst = (bf16*)(ws + WS_WQKV) + (size_t)3072 * 1024; K = 1024; Nsrc = 1536; ncols = 1536; scale = 0.125f * 1.4426950408889634f; }
    else if ((r -= I_Q) < I_Q) { src = P.in[8] + (size_t)1024 * 1536; gain = P.in[1] + 3 * 1024; dst = (bf16*)(ws + WS_WQ3); K = 1024; Nsrc = 1536; ncols = 1536; scale = 0.125f * 1.4426950408889634f; }
    else if ((r -= I_Q) < 2 * I_O) { const int l = r / I_O; r -= l * I_O; src = P.in[9] + (size_t)l * 512 * 1024; gain = nullptr; dst = (bf16*)(ws + WS_WO + (size_t)l * MiB); K = 512; Nsrc = 1024; ncols = 1024; }
    else if ((r -= 2 * I_O) < 4 * I_UP) { const int l = r / I_UP; r -= l * I_UP; src = P.in[10] + (size_t)l * 1024 * 4096; gain = P.in[2] + l * 1024; dst = (bf16*)(ws + WS_WUP + (size_t)l * 8 * MiB); K = 1024; Nsrc = 4096; ncols = 4096; }
    else { r -= 4 * I_UP; const int l = r / I_DN; r -= l * I_DN; src = P.in[11] + (size_t)l * 4096 * 1024; gain = nullptr; dst = (bf16*)(ws + WS_WDN + (size_t)l * 8 * MiB); K = 4096; Nsrc = 1024; ncols = 1024; }
    const int nblk = ncols / 32, kb = r / nblk, nb = r % nblk, k0 = 64 * kb, n0 = 32 * nb;
    int s0 = n0;
    if (mode == 1 && n0 >= 1024) { const int t = (n0 - 1024) >> 8, wv = (n0 - 1024) & 255; s0 = (wv < 128) ? (1024 + 128 * t + wv) : (2048 + 128 * t + (wv - 128)); }
    T.src = src + (size_t)k0 * Nsrc + s0; T.gain = gain ? gain + k0 : nullptr; T.dst = dst + (size_t)n0 * K + k0; T.K = K; T.Nsrc = Nsrc; T.scale = scale;
}
__device__ __forceinline__ void titem_load(const TItem& T, int lane, float (&v)[32]) {
    const float* p = T.src + (size_t)(lane >> 5) * T.Nsrc + (lane & 31);
#pragma unroll
    for (int i = 0; i < 32; ++i) v[i] = __builtin_nontemporal_load(p + (size_t)(2 * i) * T.Nsrc);
}
__device__ __forceinline__ void titem_store(const TItem& T, int lane, const float (&v)[32], LAS float* scr) {
#pragma unroll
    for (int i = 0; i < 32; ++i) scr[(2 * i + (lane >> 5)) * 33 + (lane & 31)] = v[i];
    const int c = lane & 7;
    f32x4 g0 = (f32x4){1.f, 1.f, 1.f, 1.f}, g1 = g0;
    if (T.gain) { g0 = *(const f32x4*)(T.gain + 8 * c); g1 = *(const f32x4*)(T.gain + 8 * c + 4); }
    g0 = g0 * T.scale; g1 = g1 * T.scale;
    asm volatile("s_waitcnt lgkmcnt(0)" ::: "memory");
#pragma unroll
    for (int j = 0; j < 4; ++j) { const int n = (lane >> 3) + 8 * j; const LAS float* s = scr + (8 * c) * 33 + n;
        u32x4 o; o.x = pk2(s[0 * 33] * g0[0], s[1 * 33] * g0[1]); o.y = pk2(s[2 * 33] * g0[2], s[3 * 33] * g0[3]); o.z = pk2(s[4 * 33] * g1[0], s[5 * 33] * g1[1]); o.w = pk2(s[6 * 33] * g1[2], s[7 * 33] * g1[3]);
        *(u32x4*)(T.dst + (size_t)n * T.K + 8 * c) = o; }
    asm volatile("s_waitcnt lgkmcnt(0)" ::: "memory");
}
__device__ __forceinline__ void prep_phase(const Params& P, LAS unsigned char* lds) {
    const int tid = fresh_tid(), lane = tid & 63, wave = __builtin_amdgcn_readfirstlane(tid >> 6), gw = blockIdx.x * NWAVES + wave, ngw = gridDim.x * NWAVES;
    LAS float* scr = (LAS float*)(lds + wave * 16384);
    constexpr int NITEMS = 2 * 16 * 96 + 2 * 16 * 32 + 16 * 96 + 2 * 16 * 48 + 2 * 8 * 32 + 4 * 16 * 128 + 4 * 64 * 32;
    {
        TItem cur, nxt; float v[32], vn[32]; int it = gw;
        if (it < NITEMS) { titem_decode(P, it, cur); titem_load(cur, lane, v); }
        while (it < NITEMS) {
            const int itn = it + ngw; const bool hasn = itn < NITEMS;
            if (hasn) { titem_decode(P, itn, nxt); titem_load(nxt, lane, vn); }
            titem_store(cur, lane, v, scr);
            if (hasn) { cur = nxt;
#pragma unroll
                for (int i = 0; i < 32; ++i) v[i] = vn[i]; }
            it = itn;
        }
    }
    const float* x = P.in[0]; bf16* hb = (bf16*)(P.ws + WS_HB); float* ssq = (float*)(P.ws + WS_SSQ);
    for (int m0 = gw * 4; m0 < M; m0 += ngw * 4) {
        f32x4 v[4][4];
#pragma unroll
        for (int rr = 0; rr < 4; ++rr) { const f32x4* xr = (const f32x4*)(x + (size_t)(m0 + rr) * D) + lane;
#pragma unroll
            for (int j = 0; j < 4; ++j) v[rr][j] = __builtin_nontemporal_load(xr + 64 * j); }
#pragma unroll
        for (int rr = 0; rr < 4; ++rr) { float s = 0.f;
#pragma unroll
            for (int j = 0; j < 4; ++j) s += (v[rr][j][0] * v[rr][j][0] + v[rr][j][1] * v[rr][j][1]) + (v[rr][j][2] * v[rr][j][2] + v[rr][j][3] * v[rr][j][3]);
#pragma unroll
            for (int o = 1; o < 64; o <<= 1) s += __shfl_xor(s, o);
            u32x2* o8 = (u32x2*)(hb + (size_t)(m0 + rr) * D) + lane;
#pragma unroll
            for (int j = 0; j < 4; ++j) { u32x2 w; w.x = pk2(v[rr][j][0], v[rr][j][1]); w.y = pk2(v[rr][j][2], v[rr][j][3]); o8[64 * j] = w; }
            if (lane < 16) ssq[(size_t)(m0 + rr) * 16 + lane] = (lane == 0) ? s : 0.f; }
    }
}

__device__ __forceinline__ void unpack8(const u32x4 u, float (&f)[8]) { f[0] = bflo(u.x); f[1] = bfhi(u.x); f[2] = bflo(u.y); f[3] = bfhi(u.y); f[4] = bflo(u.z); f[5] = bfhi(u.z); f[6] = bflo(u.w); f[7] = bfhi(u.w); }
__device__ __forceinline__ void conv_phase(const float* __restrict__ cw, const bf16* __restrict__ Bb, const bf16* __restrict__ CU, bf16* __restrict__ Y) {
    const int tid = fresh_tid(), lane = tid & 63, wave = __builtin_amdgcn_readfirstlane(tid >> 6), gw = blockIdx.x * NWAVES + wave, ngw = gridDim.x * NWAVES;
    constexpr int TR = 32;
    for (int ui = gw; ui < (M / TR) * 2; ui += ngw) {
        const int t0 = (ui >> 1) * TR, col = (ui & 1) * 512 + lane * 8;
        float w0[8], w1[8], w2[8], p1[8], p2[8];
#pragma unroll
        for (int j = 0; j < 8; ++j) { w0[j] = cw[col + j]; w1[j] = cw[1024 + col + j]; w2[j] = cw[2048 + col + j]; p1[j] = 0.f; p2[j] = 0.f; }
        if ((t0 & (SEQ - 1)) != 0) { unpack8(*(const u32x4*)(CU + (size_t)(t0 - 1) * 1024 + col), p1); unpack8(*(const u32x4*)(CU + (size_t)(t0 - 2) * 1024 + col), p2); }
#pragma unroll 4
        for (int t = 0; t < TR; ++t) {
            const size_t off = (size_t)(t0 + t) * 1024 + col;
            float c[8], b[8]; unpack8(*(const u32x4*)(CU + off), c); unpack8(*(const u32x4*)(Bb + off), b);
            float y[8];
#pragma unroll
            for (int j = 0; j < 8; ++j) { y[j] = b[j] * (w0[j] * c[j] + w1[j] * p1[j] + w2[j] * p2[j]); p2[j] = p1[j]; p1[j] = c[j]; }
            u32x4 w; w.x = pk2(y[0], y[1]); w.y = pk2(y[2], y[3]); w.z = pk2(y[4], y[5]); w.w = pk2(y[6], y[7]);
            *(u32x4*)(Y + off) = w;
        }
    }
}

constexpr int KROW = 144, VROW = 160, KL_BYTES = 256 * KROW;
__device__ __forceinline__ s16x4 vtr(const LAS unsigned char* p) { return __builtin_bit_cast(s16x4, __builtin_amdgcn_ds_read_tr16_b64_v4i16((LAS s16x4*)p)); }
__device__ __forceinline__ void sub_geom(int idx, int sp, int& g, int& dil, int& r, int& n) { g = idx >> 4; const int sub = idx & 15, ld = 2 * g, nb = 16 >> ld; dil = 1 << ld; r = sub >> (4 - ld); n = sp * nb + (sub & (nb - 1)); }
__device__ __forceinline__ void attn_prefetch(const bf16* __restrict__ kv, const bf16* __restrict__ q, int idx, int b, int h, int sp, int tid, int w, int fr, int fq,
                                              u32x4 (&kreg)[4], u32x4 (&vreg)[4], bf16x8 (&qreg)[2]) {
    int g, dil, r, n; sub_geom(idx, sp, g, dil, r, n);
    const int pbase = r * (SEQ >> (2 * g)) + (n - 1) * 128;
    const bf16* kp = kv + ((size_t)((b * 3 + g) * 16 + h) * SEQ + pbase) * 64;
    const bf16* vp = kp + (size_t)8 * SEQ * 64;
#pragma unroll
    for (int i = 0; i < 4; ++i) {
        const int c4 = tid + 512 * i;
        if (i >= 2 || n > 0) { kreg[i] = *(const u32x4*)(kp + c4 * 8); vreg[i] = *(const u32x4*)(vp + c4 * 8); }
        else { kreg[i] = (u32x4){0u, 0u, 0u, 0u}; vreg[i] = (u32x4){0u, 0u, 0u, 0u}; }
    }
    const bf16* qp = q + ((size_t)((b * 3 + g) * 8 + h) * SEQ + pbase + 128 + 16 * w + fr) * 64 + 8 * fq;
    qreg[0] = *(const bf16x8*)qp; qreg[1] = *(const bf16x8*)(qp + 32);
}
#define ATT_BAR() do { asm volatile("s_waitcnt lgkmcnt(0)" ::: "memory"); __builtin_amdgcn_s_barrier(); asm volatile("" ::: "memory"); } while (0)
__device__ __forceinline__ void attn_phase(LAS unsigned char* lds, const bf16* __restrict__ kv, const bf16* __restrict__ q, bf16* og0, bf16* og1, bf16* og2, float* lse3, int item) {
    const int tid = fresh_tid(), lane = tid & 63, w = __builtin_amdgcn_readfirstlane(tid >> 6), fr = lane & 15, fq = lane >> 4;
    const int b = item >> 4, h = (item >> 1) & 7, sp = item & 1;
    constexpr float LOG2E = 1.4426950408889634f, LN2 = 0.6931471805599453f;
    const float slope2 = exp2f(-(float)(h + 1)) * LOG2E;
    constexpr int ABUF = KL_BYTES + 256 * VROW;
    u32x4 kreg[4], vreg[4]; bf16x8 q1[2], q2[2];
    const int part = tid & 7, rbase = tid >> 3;
#define ATT_WRITE(bufsel) do { LAS unsigned char* kb_ = lds + (bufsel) * ABUF; _Pragma("unroll") for (int i = 0; i < 4; ++i) { const int row = rbase + 64 * i; \
        *(LAS u32x4*)(kb_ + row * KROW + part * 16) = kreg[i]; *(LAS u32x4*)(kb_ + KL_BYTES + row * VROW + part * 16) = vreg[i]; } } while (0)
    attn_prefetch(kv, q, 0, b, h, sp, tid, w, fr, fq, kreg, vreg, q2);
    ATT_BAR();
    ATT_WRITE(0); q1[0] = q2[0]; q1[1] = q2[1];
    attn_prefetch(kv, q, 1, b, h, sp, tid, w, fr, fq, kreg, vreg, q2);
    for (int idx = 0; idx < 48; ++idx) {
        int g, dil, r, n; sub_geom(idx, sp, g, dil, r, n);
        ATT_BAR();
        bf16x8 qf[2] = {q1[0], q1[1]};
        if (idx + 1 < 48) { ATT_WRITE((idx + 1) & 1); q1[0] = q2[0]; q1[1] = q2[1]; }
        if (idx + 2 < 48) attn_prefetch(kv, q, idx + 2, b, h, sp, tid, w, fr, fq, kreg, vreg, q2);
        LAS unsigned char* Kl = lds + (idx & 1) * ABUF; LAS unsigned char* Vl = Kl + KL_BYTES;
        f32x4 acc[9];
        const LAS unsigned char* kbase = Kl + (16 * w + fr) * KROW + fq * 16;
        bf16x8 kf[9][2];
#pragma unroll
        for (int t = 0; t < 9; ++t) { kf[t][0] = *(const LAS bf16x8*)(kbase + t * 16 * KROW); kf[t][1] = *(const LAS bf16x8*)(kbase + t * 16 * KROW + 64); }
        __builtin_amdgcn_sched_barrier(0);
#pragma unroll
        for (int t = 0; t < 9; ++t) {
            const float ci = (n == 0 && w + t < 8) ? -1.0e30f : 0.f;
            acc[t] = __builtin_amdgcn_mfma_f32_16x16x32_bf16(kf[t][0], qf[0], (f32x4){ci, ci, ci, ci}, 0, 0, 0);
        }
#pragma unroll
        for (int t = 0; t < 9; ++t) acc[t] = __builtin_amdgcn_mfma_f32_16x16x32_bf16(kf[t][1], qf[1], acc[t], 0, 0, 0);
        const float sd = slope2 * (float)dil;
        float mx4[4] = {-3.0e38f, -3.0e38f, -3.0e38f, -3.0e38f};
#pragma unroll
        for (int t = 0; t < 9; ++t)
#pragma unroll
            for (int e = 0; e < 4; ++e) {
                const int j = 128 + fr - 16 * t - 4 * fq - e;
                float s = acc[t][e] - sd * (float)j;
                bool ok = true;
                if (t == 0) ok = (j <= 128);
                if (t == 8) ok = (j >= 0);
                s = ok ? s : -INFINITY;
                acc[t][e] = s; mx4[e] = fmaxf(mx4[e], s);
            }
        float mx = quad16_max(fmaxf(fmaxf(mx4[0], mx4[1]), fmaxf(mx4[2], mx4[3])));
        float l4[4] = {0.f, 0.f, 0.f, 0.f};
#pragma unroll
        for (int t = 0; t < 9; ++t)
#pragma unroll
            for (int e = 0; e < 4; ++e) { const float p = __builtin_amdgcn_exp2f(acc[t][e] - mx); acc[t][e] = p; l4[e] += p; }
        float l = (l4[0] + l4[1]) + (l4[2] + l4[3]);
        l = quad16_sum(l);
        f32x4 o[4];
#pragma unroll
        for (int dt = 0; dt < 4; ++dt) o[dt] = (f32x4){0.f, 0.f, 0.f, 0.f};
        const LAS unsigned char* vbase = Vl + (16 * w + 4 * fq + (fr >> 2)) * VROW + (fr & 3) * 8;
#pragma unroll
        for (int kk = 0; kk < 5; ++kk) {
            const int t0 = 2 * kk, t1 = (2 * kk + 1 < 9) ? 2 * kk + 1 : 8;
            bf16x8 pf;
            { const unsigned a0 = pk2(acc[t0][0], acc[t0][1]), a1 = pk2(acc[t0][2], acc[t0][3]);
              unsigned b0 = 0u, b1 = 0u; if (2 * kk + 1 < 9) { b0 = pk2(acc[t1][0], acc[t1][1]); b1 = pk2(acc[t1][2], acc[t1][3]); }
              const u32x4 pw = (u32x4){a0, a1, b0, b1}; pf = __builtin_bit_cast(bf16x8, pw); }
#pragma unroll
            for (int dt = 0; dt < 4; ++dt) {
                const s16x4 lo = vtr(vbase + t0 * 16 * VROW + dt * 32), hi = vtr(vbase + t1 * 16 * VROW + dt * 32);
                const bf16x8 vf = (bf16x8){lo[0], lo[1], lo[2], lo[3], hi[0], hi[1], hi[2], hi[3]};
                o[dt] = __builtin_amdgcn_mfma_f32_16x16x32_bf16(vf, pf, o[dt], 0, 0, 0);
            }
        }
        const int qtok = b * SEQ + (n * 128 + 16 * w + fr) * dil + r;
        const float inv_l = 1.0f / l, lse1 = (mx + log2f(l)) * LN2;
        bf16* op = (g == 0 ? og0 : (g == 1 ? og1 : og2)) + (size_t)qtok * OD + h * 64 + 16 * (fq & 1) + 8 * (fq >> 1);
        u32x2 pk[4];
#pragma unroll
        for (int dt = 0; dt < 4; ++dt) { pk[dt].x = pk2(o[dt][0] * inv_l, o[dt][1] * inv_l); pk[dt].y = pk2(o[dt][2] * inv_l, o[dt][3] * inv_l); }
#pragma unroll
        for (int pr = 0; pr < 2; ++pr) {
            const auto rx = __builtin_amdgcn_permlane16_swap(pk[2 * pr].x, pk[2 * pr + 1].x, false, false);
            const auto ry = __builtin_amdgcn_permlane16_swap(pk[2 * pr].y, pk[2 * pr + 1].y, false, false);
            const u32x4 wv = (u32x4){(unsigned)rx[0], (unsigned)ry[0], (unsigned)rx[1], (unsigned)ry[1]};
            *(u32x4*)(op + 32 * pr) = wv; }
        if (fq == 0) lse3[(size_t)g * M * 8 + (size_t)qtok * 8 + h] = lse1;
    }
    asm volatile("s_waitcnt vmcnt(0)" ::: "memory"); __syncthreads();
    {
        const int tok0 = b * SEQ + sp * 2048;
        const float* ls0 = lse3 + (size_t)tok0 * 8 + h; const float* ls1 = ls0 + (size_t)M * 8; const float* ls2 = ls1 + (size_t)M * 8;
        const size_t obase = (size_t)tok0 * OD + h * 64 + (tid & 7) * 8;
        for (int k0 = 0; k0 < 32; k0 += 4) {
            float lv[4][3]; u32x4 r0[4], r1[4], r2[4];
#pragma unroll
            for (int k = 0; k < 4; ++k) { const int t = (tid >> 3) + 64 * (k0 + k); lv[k][0] = ls0[t * 8]; lv[k][1] = ls1[t * 8]; lv[k][2] = ls2[t * 8];
                const size_t off = obase + (size_t)t * OD; r0[k] = *(const u32x4*)(og0 + off); r1[k] = *(const u32x4*)(og1 + off); r2[k] = *(const u32x4*)(og2 + off); }
#pragma unroll
            for (int k = 0; k < 4; ++k) { const int t = (tid >> 3) + 64 * (k0 + k); const size_t off = obase + (size_t)t * OD;
                const float mm = fmaxf(lv[k][0], fmaxf(lv[k][1], lv[k][2])); float e0 = __expf(lv[k][0] - mm), e1 = __expf(lv[k][1] - mm), e2 = __expf(lv[k][2] - mm);
                const float inv = 1.0f / (e0 + e1 + e2); e0 *= inv; e1 *= inv; e2 *= inv;
                float a0[8], a1[8], a2[8], y[8]; unpack8(r0[k], a0); unpack8(r1[k], a1); unpack8(r2[k], a2);
#pragma unroll
                for (int j = 0; j < 8; ++j) y[j] = a0[j] * e0 + a1[j] * e1 + a2[j] * e2;
                u32x4 wv; wv.x = pk2(y[0], y[1]); wv.y = pk2(y[2], y[3]); wv.z = pk2(y[4], y[5]); wv.w = pk2(y[6], y[7]);
                *(u32x4*)(og0 + off) = wv; }
        }
    }
}

__device__ __forceinline__ void final_phase(float* out, const bf16* __restrict__ hb, const float* __restrict__ gain) {
    const int tid = fresh_tid(), lane = tid & 63, wave = __builtin_amdgcn_readfirstlane(tid >> 6), gw = blockIdx.x * NWAVES + wave, ngw = gridDim.x * NWAVES;
    f32x4 gv[2][2];
#pragma unroll
    for (int j = 0; j < 2; ++j) { gv[j][0] = *(const f32x4*)(gain + 512 * j + lane * 8); gv[j][1] = *(const f32x4*)(gain + 512 * j + lane * 8 + 4); }
    for (int m = gw; m < M; m += ngw) {
        float v[2][8]; float s = 0.f;
#pragma unroll
        for (int j = 0; j < 2; ++j) { unpack8(*(const u32x4*)(hb + (size_t)m * D + 512 * j + lane * 8), v[j]);
#pragma unroll
            for (int e = 0; e < 8; ++e) s += v[j][e] * v[j][e]; }
#pragma unroll
        for (int o = 1; o < 64; o <<= 1) s += __shfl_xor(s, o);
        const float rstd = rsqrtf(s * (1.0f / 1024.0f) + 1e-5f);
#pragma unroll
        for (int j = 0; j < 2; ++j) { float* op = out + (size_t)m * D + 512 * j + lane * 8;
            __builtin_nontemporal_store((f32x4){v[j][0], v[j][1], v[j][2], v[j][3]} * rstd * gv[j][0], (f32x4*)op); __builtin_nontemporal_store((f32x4){v[j][4], v[j][5], v[j][6], v[j][7]} * rstd * gv[j][1], (f32x4*)(op + 4)); }
    }
}

#define XB_TMO      128
#define XB_XCNT(j)  (256  + 64 * (j))
#define XB_XSUB(j)  (1280 + 64 * (j))
#define XB_XGEN(j)  (2304 + 64 * (j))
#define XB_TOP      3328
#define XB_TOPGEN   3392
#define XCD_BAR_WORDS 3456
#define XB_SPIN_CAP (1u << 18)

__device__ __forceinline__ unsigned xb_ld(unsigned* p)              { return __hip_atomic_load(p, __ATOMIC_RELAXED, __HIP_MEMORY_SCOPE_AGENT); }
__device__ __forceinline__ unsigned xb_add(unsigned* p, unsigned v) { return __hip_atomic_fetch_add(p, v, __ATOMIC_RELAXED, __HIP_MEMORY_SCOPE_AGENT); }
__device__ __forceinline__ unsigned xb_xcc_id() { return (unsigned)__builtin_amdgcn_s_getreg((3 << 11) | 20) & 0xFu; }
#define XB_SPIN(cond, bar) do { unsigned _sp = 0; while (cond) { __builtin_amdgcn_s_sleep(1); \
    if ((++_sp & 255u) == 0u) { if (xb_ld(&(bar)[XB_TMO])) break; if (_sp > XB_SPIN_CAP) { atomicAdd(&(bar)[XB_TMO], 1u); break; } } } } while (0)

struct XcdBarrier {
    unsigned* bar; unsigned x;
    volatile LAS unsigned* st;
};

__device__ __forceinline__ XcdBarrier xcd_barrier_post(unsigned* bar, volatile LAS unsigned* st) {
    XcdBarrier b; b.bar = bar; b.x = xb_xcc_id(); b.st = st;
    if (threadIdx.x == 0) (void)xb_add(&bar[XB_XCNT(b.x)], 1u);
    return b;
}
__device__ __forceinline__ void xcd_barrier_complete(unsigned* bar, unsigned x, unsigned& nloc, unsigned& nx) {
    const unsigned G = gridDim.x * gridDim.y * gridDim.z;
    unsigned sum, cnt, mine, sp = 0u;
    for (;;) {
        sum = 0u; cnt = 0u; mine = 0u;
#pragma unroll
        for (unsigned j = 0; j < 16; ++j) { const unsigned c = xb_ld(&bar[XB_XCNT(j)]); sum += c; cnt += (c > 0u) ? 1u : 0u; mine = (j == x) ? c : mine; }
        if (sum == G) break;
        __builtin_amdgcn_s_sleep(1);
        if ((++sp & 255u) == 0u) { if (xb_ld(&bar[XB_TMO])) break; if (sp > XB_SPIN_CAP) { atomicAdd(&bar[XB_TMO], 1u); break; } }
    }
    nloc = mine > 0u ? mine : 1u; nx = cnt > 0u ? cnt : 1u;
}

__device__ __forceinline__ void xcd_barrier(const XcdBarrier& b) {
    asm volatile("s_waitcnt vmcnt(0)" ::: "memory");
    __syncthreads();
    if (threadIdx.x == 0) {
        unsigned* bar = b.bar;
        __builtin_amdgcn_s_waitcnt(0);
        unsigned nloc = b.st[0], nx = b.st[1];
        if (nloc == 0u) { xcd_barrier_complete(bar, b.x, nloc, nx); b.st[0] = nloc; b.st[1] = nx; }
        const unsigned old = xb_add(&bar[XB_XSUB(b.x)], 1u);
        const unsigned gen = old / nloc;
        if (old + 1u == (gen + 1u) * nloc) {
            __builtin_amdgcn_fence(__ATOMIC_RELEASE, "agent");
            asm volatile("s_waitcnt vmcnt(0)" ::: "memory");
            const unsigned og = xb_add(&bar[XB_TOP], 1u);
            const unsigned tg = og / nx;
            if (og + 1u == (tg + 1u) * nx) xb_add(&bar[XB_TOPGEN], 1u);
            else XB_SPIN(xb_ld(&bar[XB_TOPGEN]) == tg, bar);
            __builtin_amdgcn_fence(__ATOMIC_ACQUIRE, "agent");
            xb_add(&bar[XB_XGEN(b.x)], 1u);
            asm volatile("s_waitcnt vmcnt(0)" ::: "memory");
        } else {
            XB_SPIN(xb_ld(&bar[XB_XGEN(b.x)]) == gen, bar);
            __builtin_amdgcn_fence(__ATOMIC_ACQUIRE, "agent");
            asm volatile("s_waitcnt vmcnt(0)" ::: "memory");
        }
    }
    __syncthreads();
}


__global__ void __launch_bounds__(NTHREADS, 2) yoco_fwd(Params P) {
    extern __shared__ __attribute__((aligned(16))) unsigned char lds_raw[];
    LAS unsigned char* lds = (LAS unsigned char*)lds_raw;
    cg::grid_group grid = cg::this_grid();
    volatile LAS unsigned* bst = (volatile LAS unsigned*)(lds + LDS_BYTES - 64);
    if (threadIdx.x < 2) bst[threadIdx.x] = 0u;
    __syncthreads();
    if (blockIdx.x == 0) { for (int i = threadIdx.x; i < XCD_BAR_WORDS; i += NTHREADS) __hip_atomic_store((unsigned*)P.ws + i, 0u, __ATOMIC_RELAXED, __HIP_MEMORY_SCOPE_AGENT); }
    const int G = gridDim.x, bx = blockIdx.x;
    unsigned char* ws = P.ws;
    bf16* hb = (bf16*)(ws + WS_HB); float* ssq = (float*)(ws + WS_SSQ); float* ssqm = (float*)(ws + WS_SSQ2);
    bf16* bbuf = (bf16*)(ws + WS_R1); bf16* cubuf = (bf16*)(ws + WS_R1 + 128 * MiB); bf16* kvb = (bf16*)(ws + WS_R1);
    bf16* ybuf = (bf16*)(ws + WS_R2); bf16* hid = (bf16*)(ws + WS_R2); bf16* qb = (bf16*)(ws + WS_R2); bf16* ob = (bf16*)(ws + WS_R2 + 192 * MiB);
    float* out = P.out;

#ifndef SKIP_PREP
    prep_phase(P, lds);
#endif
    grid.sync();
    const XcdBarrier bar = xcd_barrier_post((unsigned*)P.ws, bst);

    for (int l = 0; l < 4; ++l) {
        if (l < 2) {
            for (int c = 0; c < M / MCA; ++c) {
                const size_t ro = (size_t)c * MCA;
                {
                    pg8::Gemm g{hb + ro * D, (const bf16*)(ws + WS_WAIN + (size_t)l * 6 * MiB) + (size_t)1024 * 1024, MCA, 2048, D}; pg8::StaticOrder S; S.init(MCA, 2048, G, bx);
                    pg8::EpiCU E{cubuf + ro * D, ssq + ro * 16};
                    GEMM_PHASE<pg8::EpiCU, pg8::StaticOrder, true, true>(lds, g, S, E);
                }
                xcd_barrier(bar);
                {
                    pg8::Gemm g{hb + ro * D, (const bf16*)(ws + WS_WAIN + (size_t)l * 6 * MiB), MCA, 1024, D}; pg8::StaticOrder S; S.init(MCA, 1024, G, bx);
                    pg8::EpiBConv E{cubuf + ro * D, ybuf + ro * D, P.in[4] + (size_t)l * 3 * 1024, ssq + ro * 16};
                    GEMM_PHASE<pg8::EpiBConv, pg8::StaticOrder, true, true>(lds, g, S, E);
                }
                xcd_barrier(bar);
                {
                    pg8::Gemm g{ybuf + ro * D, (const bf16*)(ws + WS_WAOUT + (size_t)l * 2 * MiB), MCA, D, D}; pg8::StaticOrder S; S.init(MCA, D, G, bx);
                    pg8::EpiRes E{hb + ro * D, ssqm + ro * 16, nullptr};
                    GEMM_PHASE<pg8::EpiRes, pg8::StaticOrder, true, true>(lds, g, S, E);
                }
                if (c + 1 == M / MCA) xcd_barrier(bar); else __syncthreads();
            }
        } else {
            {
                const bool first = (l == 2);
                pg8::Gemm g{hb, (const bf16*)(ws + (first ? WS_WQKV : WS_WQ3)), M, first ? NQKV : NQ, D}; pg8::StaticOrder S; S.init(M, g.N, G, bx);
                pg8::EpiQKV E{kvb, qb, first ? NKV : 0, ssq};
                GEMM_PHASE<pg8::EpiQKV, pg8::StaticOrder, true, true>(lds, g, S, E);
            }
            xcd_barrier(bar);
#ifndef SKIP_ATTN
            for (int item = bx; item < 256; item += G) attn_phase(lds, kvb, qb, ob, (bf16*)(ws + WS_OG1), (bf16*)(ws + WS_OG2), (float*)(ws + WS_LSE3), item);
#endif
            xcd_barrier(bar);
            {
                pg8::Gemm g{ob, (const bf16*)(ws + WS_WO + (size_t)(l - 2) * MiB), M, D, OD}; pg8::StaticOrder S; S.init(M, D, G, bx);
                pg8::EpiRes E{hb, ssqm, nullptr};
                GEMM_PHASE<pg8::EpiRes, pg8::StaticOrder, true, true>(lds, g, S, E);
            }
            xcd_barrier(bar);
        }
        for (int c = 0; c < M / MCH; ++c) {
            const size_t ro = (size_t)(M / MCH - 1 - c) * MCH; bf16* hidc = hid + (size_t)(c & 1) * MCH * FF;
            {
                pg8::Gemm g{hb + ro * D, (const bf16*)(ws + WS_WUP + (size_t)l * 8 * MiB), MCH, FF, D}; pg8::StaticOrder S; S.init(MCH, FF, G, bx);
                pg8::EpiScaleBf16<1> E{hidc, FF, hidc, FF, 1 << 30, nullptr};
                GEMM_PHASE<pg8::EpiScaleBf16<1>, pg8::StaticOrder, true, true>(lds, g, S, E);
            }
            xcd_barrier(bar);
            {
                pg8::Gemm g{hidc, (const bf16*)(ws + WS_WDN + (size_t)l * 8 * MiB), MCH, D, FF}; pg8::StaticOrder S; S.init(MCH, D, G, bx);
                pg8::EpiRes E{hb + ro * D, ssq + ro * 16, ssqm + ro * 16};
                GEMM_PHASE<pg8::EpiRes, pg8::StaticOrder, true, true>(lds, g, S, E);
            }
            if (c + 1 == M / MCH) xcd_barrier(bar); else __syncthreads();
        }
    }
#ifndef SKIP_FINAL
    final_phase(out, hb, P.in[12]);
#endif
}

extern "C" void kernel_launch(void* const* d_in, const int* in_sizes, int n_in, void* d_out, int out_size, void* d_ws, size_t ws_size, hipStream_t stream) {
    static int grid = 0;
    if (grid == 0) {
        if (n_in != 13 || out_size != M * D || ws_size < WS_END) { fprintf(stderr, "kernel_launch: unexpected shapes (n_in %d out %d ws %zu)\n", n_in, out_size, ws_size); grid = -1; return; }
        int dev = 0, cus = 0, per_cu = 0;
        hipGetDevice(&dev); hipDeviceGetAttribute(&cus, hipDeviceAttributeMultiprocessorCount, dev);
        if (hipFuncSetAttribute((const void*)yoco_fwd, hipFuncAttributeMaxDynamicSharedMemorySize, LDS_BYTES) != hipSuccess) { fprintf(stderr, "kernel_launch: hipFuncSetAttribute failed\n"); grid = -1; return; }
        if (hipOccupancyMaxActiveBlocksPerMultiprocessor(&per_cu, (const void*)yoco_fwd, NTHREADS, LDS_BYTES) != hipSuccess || per_cu < 1) { fprintf(stderr, "kernel_launch: occupancy query says %d\n", per_cu); per_cu = 1; }
        (void)hipGetLastError();
        grid = cus;
        if (grid != 256) fprintf(stderr, "kernel_launch: %d CUs (expected 256)\n", grid);
    }
    if (grid < 0) return;
    Params p{};
    for (int i = 0; i < 13; ++i) p.in[i] = (const float*)d_in[i];
    p.out = (float*)d_out; p.ws = (unsigned char*)d_ws;
    void* args[] = {&p};
    hipError_t e = hipLaunchCooperativeKernel((const void*)yoco_fwd, dim3(grid), dim3(NTHREADS), args, LDS_BYTES, stream);
    if (e != hipSuccess) fprintf(stderr, "kernel_launch: cooperative launch failed: %s (grid %d)\n", hipGetErrorString(e), grid);
}
```
